# Optimizing an MI355X kernel written in HIP

```python
import jax, jax.numpy as jnp
from jax import lax
import numpy as np

D_MODEL = 1024
BATCH = 16
SEQ = 2048
DEPTH = 2
DEC_BATCH = 8
DEC_SEQ = 32
PAST_LEN = 2048

CHUNK = 64
HEAD_DIM = 64
H_A = 8
H_B = 8
LEFT_CHUNKS_A = 8
REL_CLIP_A = 128
N_REL_A = 2 * REL_CLIP_A + 1
SB_BLOCK = 128
W_A = H_A * HEAD_DIM
W_B = H_B * HEAD_DIM
W_AB = W_A + W_B
IN_AB = 4 * W_A + 4 * W_B
AB_SPLITS = (W_A, 2 * W_A, 3 * W_A, 4 * W_A, 4 * W_A + W_B, 4 * W_A + 2 * W_B, 4 * W_A + 3 * W_B)
H_C = 16
KV_C = 4
G_C = H_C // KV_C
WINDOW_C = 128
LEFT_CHUNKS_C = WINDOW_C // CHUNK
W_C = H_C * HEAD_DIM
KVW_C = KV_C * HEAD_DIM
IN_C = 2 * W_C + 2 * KVW_C
C_SPLITS = (W_C, W_C + KVW_C, W_C + 2 * KVW_C)
ROPE_THETA = 10000.0
RMS_EPS = 1e-6
NEG_INF = -1e30
N_AB = (DEPTH + 1) // 2
N_C = DEPTH // 2

kernel_name = 'hybrid_chunk_streaming_encoder_step'


def _rmsnorm(x, g):
    xf = x.astype(jnp.float32)
    r = lax.rsqrt(jnp.mean(xf * xf, axis=-1, keepdims=True) + RMS_EPS)
    return (xf * r * g.astype(jnp.float32)).astype(x.dtype)


def _rope(x, pos):
    half = HEAD_DIM // 2
    inv = ROPE_THETA ** (-jnp.arange(half, dtype=jnp.float32) * (2.0 / HEAD_DIM))
    ang = pos.astype(jnp.float32)[:, None] * inv[None, :]
    cos, sin = jnp.cos(ang)[:, None, :], jnp.sin(ang)[:, None, :]
    xf = x.astype(jnp.float32)
    x1, x2 = xf[..., :half], xf[..., half:]
    return jnp.concatenate([x1 * cos - x2 * sin, x2 * cos + x1 * sin], axis=-1).astype(x.dtype)


def _chunk_band(x, n_left):
    B, S = x.shape[:2]
    nC = S // CHUNK
    xp = jnp.pad(x, ((0, 0), (n_left * CHUNK, 0), (0, 0), (0, 0)))
    xp = xp.reshape(B, nC + n_left, CHUNK, *x.shape[2:])
    return jnp.concatenate([xp[:, i:i + nC] for i in range(n_left + 1)], axis=2)


def _chunk_band_mask(q_pos, k_pos, n_left):
    qc = q_pos[:, :, None] // CHUNK
    kc = k_pos[:, None, :] // CHUNK
    return (k_pos[:, None, :] >= 0) & (kc <= qc) & (kc >= qc - n_left)


def _band_attention(q, k, v, mask, bias=None, sinks=None):
    s = jnp.einsum('bcqhgd,bckhd->bchgqk', q, k).astype(jnp.float32) * (HEAD_DIM ** -0.5)
    if bias is not None:
        s = s + bias
    s = jnp.where(mask[None, :, None, None], s, NEG_INF)
    m = jnp.max(s, axis=-1, keepdims=True)
    if sinks is not None:
        sk = sinks.astype(jnp.float32)[:, :, None, None]
        m = jnp.maximum(m, sk)
        p = jnp.exp(s - m)
        denom = jnp.sum(p, axis=-1, keepdims=True) + jnp.exp(sk - m)
    else:
        p = jnp.exp(s - m)
        denom = jnp.sum(p, axis=-1, keepdims=True)
    return jnp.einsum('bchgqk,bckhd->bcqhgd', (p / denom).astype(v.dtype), v)


def _band_prompt(q, k, v, pos, n_left, groups):
    B, S, Hq, d = q.shape
    nC = S // CHUNK
    qc = q.reshape(B, nC, CHUNK, Hq // groups, groups, d)
    q_pos = pos.reshape(nC, CHUNK)
    k_pos = (jnp.arange(nC) * CHUNK)[:, None] + jnp.arange(-n_left * CHUNK, CHUNK)[None, :]
    return qc, _chunk_band(k, n_left), _chunk_band(v, n_left), q_pos, k_pos


def _band_sample(q, k, v, ck, cv, past, groups):
    B, T, Hq, d = q.shape
    L = ck.shape[1]
    qc = q.reshape(B, 1, T, Hq // groups, groups, d)
    k_all = jnp.concatenate([ck, k], axis=1)[:, None]
    v_all = jnp.concatenate([cv, v], axis=1)[:, None]
    q_pos = (past + jnp.arange(T))[None]
    k_pos = (past - L + jnp.arange(L + T))[None]
    return qc, k_all, v_all, q_pos, k_pos


def _mixer_a(q, k, v, q_pos, k_pos, table):
    mask = _chunk_band_mask(q_pos, k_pos, LEFT_CHUNKS_A)
    rel = jnp.clip(q_pos[:, :, None] - k_pos[:, None, :], -REL_CLIP_A, REL_CLIP_A) + REL_CLIP_A
    bias = jnp.moveaxis(jnp.take(table, rel, axis=1), 0, 1)[:, :, None].astype(jnp.float32)
    return _band_attention(q, k, v, mask, bias=bias)


def _mixer_c(q, k, v, q_pos, k_pos, sinks):
    mask = _chunk_band_mask(q_pos, k_pos, LEFT_CHUNKS_C)
    return _band_attention(q, k, v, mask, sinks=sinks.reshape(KV_C, G_C))


def _sb_block(q, k, v, q_pos, k_pos):
    z = jnp.einsum('bqhd,bkhd->bhqk', q, k).astype(jnp.float32) * (HEAD_DIM ** -0.5)
    causal = k_pos[None, :] < q_pos[:, None]
    log_1m = jnp.where(causal, jax.nn.log_sigmoid(-z), 0.0)
    later = lax.cumsum(log_1m, axis=3, reverse=True) - log_1m
    a = jnp.where(causal, jnp.exp(jax.nn.log_sigmoid(z) + later), 0.0)
    return jnp.einsum('bhqk,bkhd->bqhd', a.astype(v.dtype), v)


def _stick_breaking_prompt(q, k, v):
    B, S, H, d = q.shape
    nb = S // SB_BLOCK
    pos = jnp.arange(S)
    qb = q.reshape(B, nb, SB_BLOCK, H, d).transpose(1, 0, 2, 3, 4)
    pb = pos.reshape(nb, SB_BLOCK)
    out = lax.map(lambda a: _sb_block(a[0], k, v, a[1], pos), (qb, pb))
    return out.transpose(1, 0, 2, 3, 4).reshape(B, S, H, d)


def _merge(x, parts, w_out, g_post):
    y = jnp.concatenate(parts, axis=-1) @ w_out
    return x + _rmsnorm(y, g_post)


def _ab_project(x, g_pre, w_in):
    B, S, _ = x.shape
    u = _rmsnorm(x, g_pre) @ w_in
    qa, ka, va, ga, qb, kb, vb, gb = jnp.split(u, AB_SPLITS, axis=-1)
    hd = lambda t, h: t.reshape(B, S, h, HEAD_DIM)
    return hd(qa, H_A), hd(ka, H_A), hd(va, H_A), ga, hd(qb, H_B), hd(kb, H_B), hd(vb, H_B), gb


def _c_project(x, g_pre, w_in):
    B, S, _ = x.shape
    u = _rmsnorm(x, g_pre) @ w_in
    q, k, v, g = jnp.split(u, C_SPLITS, axis=-1)
    return (q.reshape(B, S, H_C, HEAD_DIM), k.reshape(B, S, KV_C, HEAD_DIM),
            v.reshape(B, S, KV_C, HEAD_DIM), g)


def _ab_layer_prompt(x, g_pre, w_in, w_out, g_post, rel_table):
    B, S, _ = x.shape
    qa, ka, va, ga, qb, kb, vb, gb = _ab_project(x, g_pre, w_in)
    pos = jnp.arange(S)
    oa = _mixer_a(*_band_prompt(qa, ka, va, pos, LEFT_CHUNKS_A, 1), rel_table).reshape(B, S, W_A)
    ob = _stick_breaking_prompt(qb, kb, vb).reshape(B, S, W_B)
    y = _merge(x, [oa * jax.nn.silu(ga), ob * jax.nn.silu(gb)], w_out, g_post)
    la = min(LEFT_CHUNKS_A * CHUNK, S)
    return y, (ka[:, S - la:], va[:, S - la:], kb, vb)


def _ab_layer_sample(x, ca_k, ca_v, cb_k, cb_v, past, g_pre, w_in, w_out, g_post, rel_table):
    B, T, _ = x.shape
    qa, ka, va, ga, qb, kb, vb, gb = _ab_project(x, g_pre, w_in)
    oa = _mixer_a(*_band_sample(qa, ka, va, ca_k, ca_v, past, 1), rel_table).reshape(B, T, W_A)
    kb_all = jnp.concatenate([cb_k, kb], axis=1)
    vb_all = jnp.concatenate([cb_v, vb], axis=1)
    ob = _sb_block(qb, kb_all, vb_all, past + jnp.arange(T), jnp.arange(past + T)).reshape(B, T, W_B)
    y = _merge(x, [oa * jax.nn.silu(ga), ob * jax.nn.silu(gb)], w_out, g_post)
    return y, (ka, va, kb, vb)


def _c_layer_prompt(x, g_pre, w_in, sinks, w_out, g_post):
    B, S, _ = x.shape
    q, k, v, g = _c_project(x, g_pre, w_in)
    pos = jnp.arange(S)
    q, k = _rope(q, pos), _rope(k, pos)
    o = _mixer_c(*_band_prompt(q, k, v, pos, LEFT_CHUNKS_C, G_C), sinks).reshape(B, S, W_C)
    y = _merge(x, [o * jax.nn.silu(g)], w_out, g_post)
    lc = min(WINDOW_C, S)
    return y, (k[:, S - lc:], v[:, S - lc:])


def _c_layer_sample(x, cc_k, cc_v, past, g_pre, w_in, sinks, w_out, g_post):
    B, T, _ = x.shape
    q, k, v, g = _c_project(x, g_pre, w_in)
    pos = past + jnp.arange(T)
    q, k = _rope(q, pos), _rope(k, pos)
    o = _mixer_c(*_band_sample(q, k, v, cc_k, cc_v, past, G_C), sinks).reshape(B, T, W_C)
    y = _merge(x, [o * jax.nn.silu(g)], w_out, g_post)
    return y, (k, v)


def setup_inputs(seed: int = 0) -> dict:
    key = jax.random.key(seed)
    ks = jax.random.split(key, 20)
    f32 = jnp.float32
    nrm = lambda k, shape, scale=1.0: scale * jax.random.normal(k, shape, f32)
    la = min(LEFT_CHUNKS_A * CHUNK, PAST_LEN)
    lc = min(WINDOW_C, PAST_LEN)
    return {
        'x_prompt': nrm(ks[0], (BATCH, SEQ, D_MODEL)),
        'x_sample': nrm(ks[1], (DEC_BATCH, DEC_SEQ, D_MODEL)),
        'cache_a_k': nrm(ks[2], (N_AB, DEC_BATCH, la, H_A, HEAD_DIM)),
        'cache_a_v': nrm(ks[3], (N_AB, DEC_BATCH, la, H_A, HEAD_DIM)),
        'cache_b_k': nrm(ks[4], (N_AB, DEC_BATCH, PAST_LEN, H_B, HEAD_DIM)),
        'cache_b_v': nrm(ks[5], (N_AB, DEC_BATCH, PAST_LEN, H_B, HEAD_DIM)),
        'cache_c_k': nrm(ks[6], (N_C, DEC_BATCH, lc, KV_C, HEAD_DIM)),
        'cache_c_v': nrm(ks[7], (N_C, DEC_BATCH, lc, KV_C, HEAD_DIM)),
        'ab_norm_pre': 1.0 + nrm(ks[8], (N_AB, D_MODEL), 0.1),
        'ab_w_in': nrm(ks[9], (N_AB, D_MODEL, IN_AB), D_MODEL ** -0.5),
        'ab_w_out': nrm(ks[10], (N_AB, W_AB, D_MODEL), W_AB ** -0.5),
        'ab_norm_post': 1.0 + nrm(ks[11], (N_AB, D_MODEL), 0.1),
        'a_rel_bias': nrm(ks[12], (N_AB, H_A, N_REL_A), 0.5),
        'c_norm_pre': 1.0 + nrm(ks[13], (N_C, D_MODEL), 0.1),
        'c_w_in': nrm(ks[14], (N_C, D_MODEL, IN_C), D_MODEL ** -0.5),
        'c_sinks': nrm(ks[15], (N_C, H_C)),
        'c_w_out': nrm(ks[16], (N_C, W_C, D_MODEL), W_C ** -0.5),
        'c_norm_post': 1.0 + nrm(ks[17], (N_C, D_MODEL), 0.1),
    }


def reference(x_prompt, x_sample, cache_a_k, cache_a_v, cache_b_k, cache_b_v, cache_c_k, cache_c_v,
              ab_norm_pre, ab_w_in, ab_w_out, ab_norm_post, a_rel_bias,
              c_norm_pre, c_w_in, c_sinks, c_w_out, c_norm_post):
    past = cache_b_k.shape[2]
    yp, ys = x_prompt, x_sample
    ab_p, ab_s, c_p, c_s = [], [], [], []
    for layer in range(DEPTH):
        i = layer // 2
        if layer % 2 == 0:
            yp, rows = _ab_layer_prompt(yp, ab_norm_pre[i], ab_w_in[i], ab_w_out[i], ab_norm_post[i], a_rel_bias[i])
            ab_p.append(rows)
            ys, rows = _ab_layer_sample(ys, cache_a_k[i], cache_a_v[i], cache_b_k[i], cache_b_v[i], past,
                                        ab_norm_pre[i], ab_w_in[i], ab_w_out[i], ab_norm_post[i], a_rel_bias[i])
            ab_s.append(rows)
        else:
            yp, rows = _c_layer_prompt(yp, c_norm_pre[i], c_w_in[i], c_sinks[i], c_w_out[i], c_norm_post[i])
            c_p.append(rows)
            ys, rows = _c_layer_sample(ys, cache_c_k[i], cache_c_v[i], past,
                                       c_norm_pre[i], c_w_in[i], c_sinks[i], c_w_out[i], c_norm_post[i])
            c_s.append(rows)
    st = lambda rows, j: jnp.stack([r[j] for r in rows])
    return (yp, ys,
            st(ab_p, 0), st(ab_p, 1), st(ab_p, 2), st(ab_p, 3), st(c_p, 0), st(c_p, 1),
            st(ab_s, 0), st(ab_s, 1), st(ab_s, 2), st(ab_s, 3), st(c_s, 0), st(c_s, 1))
```

```cpp
#include <hip/hip_runtime.h>
#include <hip/hip_cooperative_groups.h>
#include <cstdio>
namespace cg = cooperative_groups;
namespace pg8 {
#define PG8_LAS __attribute__((address_space(3)))
typedef unsigned short bf16_t;
typedef short bf16x8 __attribute__((ext_vector_type(8)));
typedef float f32x4 __attribute__((ext_vector_type(4)));
typedef unsigned u32x4 __attribute__((ext_vector_type(4)));
constexpr int BM = 256, BK = 64, HALF = 128, HTB = HALF * BK * 2  , STAGE_BYTES = 8 * HTB, NXCD = 8, WGM = 8;

__host__ __device__ __forceinline__ int lds_byte(int r, int c) { const int st = (r >> 4) * 2 + (c >> 5), rr = r & 15, cc = c & 31, ob = rr * 64 + cc * 2; return st * 1024 + (ob ^ (((ob >> 9) & 1) << 5)); }
__host__ __device__ __forceinline__ void stage_rc(int b, int& R, int& C) { const int st = b / 1024, sb = b % 1024, swz = sb ^ (((sb >> 9) & 1) << 5); R = (st >> 1) * 16 + swz / 64; C = (st & 1) * 32 + (swz % 64) / 2; }
__host__ __device__ __forceinline__ int perm32(int rho) { const int n = rho >> 4, i = rho & 15; return 8 * (i >> 2) + 4 * n + (i & 3); }

struct Unit { int pm, pn; };
struct Gemm { const bf16_t* A; const bf16_t* Bt; int M, N, K; };

struct StaticOrder {
    int nM, nN, nwg, G, c;
    __host__ __device__ void init(int M, int N, int G_, int c_) { nM = M / BM; nN = N / BM; nwg = nM * nN; G = G_; c = c_; }
    __host__ __device__ bool next(int i, Unit& u) const {
        const long L = (long)i * G + c; if (L >= nwg) return false;
        int wgid = (int)L; { const int q = nwg / NXCD, r = nwg % NXCD, xcd = wgid % NXCD, off = wgid / NXCD; wgid = (xcd < r ? xcd * (q + 1) : r * (q + 1) + (xcd - r) * q) + off; }
        const int nig = WGM * nN, gid = wgid / nig, fm = gid * WGM, gsz = (nM - fm) < WGM ? (nM - fm) : WGM;
        u.pm = fm + ((wgid % nig) % gsz); u.pn = (wgid % nig) / gsz; return true;
    }
    __device__ __forceinline__ void a_ready(const Unit&) const {}
    __device__ __forceinline__ void done(const Unit&) const {}
};
__device__ __forceinline__ unsigned cvt_pk_bf16(float lo, float hi) { unsigned r; asm volatile("v_cvt_pk_bf16_f32 %0, %1, %2" : "=v"(r) : "v"(lo), "v"(hi)); return r; }
template <class Epi, class Sched>
__device__ __forceinline__ void gemm_phase(PG8_LAS unsigned char* lds, const Gemm g, const Sched& S, const Epi& E) {
    int tid = threadIdx.x; asm volatile("" : "+v"(tid));
    const int wid = __builtin_amdgcn_readfirstlane(tid >> 6), lane = tid & 63, wr = wid >> 2, wc = wid & 3, fr = lane & 15, fq = lane >> 4;
    const int K = g.K, nt = K / BK;
    unsigned voffA[2], voffB[2];
#pragma unroll
    for (int i = 0; i < 2; ++i) { int R, C; stage_rc(tid * 16 + i * 8192, R, C); const int Rb = Epi::PERM ? ((R & ~31) + perm32(R & 31)) : R;
        voffA[i] = (unsigned)(R * K + C) * 2u; voffB[i] = (unsigned)(Rb * K + C) * 2u; }
    const size_t kstep = (size_t)(BK * 2);
    const size_t hstep = (size_t)HALF * K * 2;
    const size_t tstep = 2 * hstep;
    const unsigned ldsw = (unsigned)wid * 1024u;
    const int aoff = lds_byte(wr * 64 + fr, fq * 8), boff = lds_byte(wc * 32 + fr, fq * 8);
#define PG8_SA(b, h) (((b) * 2 + (h)) * HTB)
#define PG8_SB(b, h) ((4 + (b) * 2 + (h)) * HTB)
#define PG8_STAGE(bufoff, gbase, voff) do { _Pragma("unroll") for (int _i = 0; _i < 2; ++_i) \
        __builtin_amdgcn_global_load_lds((const unsigned*)((const char*)(gbase) + (voff)[_i]), (PG8_LAS unsigned*)(lds + (bufoff) + ldsw + _i * 8192), 16, 0, 0); } while (0)
#define PG8_LDA(dst, b, h) do { _Pragma("unroll") for (int m = 0; m < 4; ++m) _Pragma("unroll") for (int k = 0; k < 2; ++k) dst[m][k] = *(const PG8_LAS bf16x8*)(lds + PG8_SA(b, h) + aoff + m * 2048 + k * 1024); } while (0)
#define PG8_LDB(dst, b, h) do { _Pragma("unroll") for (int n = 0; n < 2; ++n) _Pragma("unroll") for (int k = 0; k < 2; ++k) dst[n][k] = *(const PG8_LAS bf16x8*)(lds + PG8_SB(b, h) + boff + n * 2048 + k * 1024); } while (0)
#define PG8_MMA(ai, bj, At, Bt) do { __builtin_amdgcn_s_setprio(1); _Pragma("unroll") for (int m = 0; m < 4; ++m) _Pragma("unroll") for (int n = 0; n < 2; ++n) _Pragma("unroll") for (int k = 0; k < 2; ++k) \
        acc[ai][bj][m][n] = __builtin_amdgcn_mfma_f32_16x16x32_bf16(Bt[n][k], At[m][k], acc[ai][bj][m][n], 0, 0, 0); __builtin_amdgcn_s_setprio(0); } while (0)
#define PG8_WAIT_V(n) asm volatile("s_waitcnt vmcnt(" #n ")" ::: "memory")
#define PG8_WAIT_L(n) asm volatile("s_waitcnt lgkmcnt(" #n ")" ::: "memory")
#define PG8_BAR __builtin_amdgcn_s_barrier()
#define PG8_SCHED __builtin_amdgcn_sched_barrier(0)
    Unit cur, nxt; int ui = 0;
    if (!S.next(0, cur)) return;
    f32x4 acc[2][2][4][2];
#pragma unroll
    for (int a = 0; a < 2; ++a)
#pragma unroll
        for (int b = 0; b < 2; ++b)
#pragma unroll
            for (int m = 0; m < 4; ++m)
#pragma unroll
                for (int n = 0; n < 2; ++n) acc[a][b][m][n] = (f32x4){0.f, 0.f, 0.f, 0.f};
    bf16x8 At[4][2], B0[2][2], B1[2][2];
    const char* cA = (const char*)g.A + (size_t)cur.pm * tstep; const char* cB = (const char*)g.Bt + (size_t)cur.pn * tstep;
    S.a_ready(cur);
    PG8_STAGE(PG8_SB(0, 0), cB, voffB); PG8_STAGE(PG8_SA(0, 0), cA, voffA); PG8_STAGE(PG8_SB(0, 1), cB + hstep, voffB); PG8_STAGE(PG8_SA(0, 1), cA + hstep, voffA);
    if (wr == 1) PG8_BAR;
    PG8_WAIT_V(4); PG8_BAR;
    PG8_STAGE(PG8_SB(1, 0), cB + kstep, voffB); PG8_STAGE(PG8_SA(1, 0), cA + kstep, voffA); PG8_STAGE(PG8_SB(1, 1), cB + hstep + kstep, voffB);
    PG8_WAIT_V(6); PG8_BAR;
    for (;;) {
        const bool has_next = S.next(ui + 1, nxt);
        const char* nA = has_next ? (const char*)g.A + (size_t)nxt.pm * tstep : cA; const char* nB = has_next ? (const char*)g.Bt + (size_t)nxt.pn * tstep : cB;
        for (int t = 0; t < nt; t += 2) {
            const bool last = (t == nt - 2);
            const char* a1 = cA + (size_t)(t + 1) * kstep;
            const char* a2 = last ? nA : cA + (size_t)(t + 2) * kstep; const char* b2 = last ? nB : cB + (size_t)(t + 2) * kstep;
            const char* a3 = a2 + kstep; const char* b3 = b2 + kstep;
            if (last && has_next) S.a_ready(nxt);
            PG8_LDB(B0, 0, 0); PG8_SCHED; PG8_LDA(At, 0, 0); PG8_STAGE(PG8_SA(1, 1), a1 + hstep, voffA);
            PG8_WAIT_L(8); PG8_BAR; PG8_WAIT_L(0); PG8_MMA(0, 0, At, B0); PG8_BAR; PG8_SCHED;
            PG8_LDB(B1, 0, 1); PG8_STAGE(PG8_SB(0, 0), b2, voffB);
            PG8_BAR; PG8_WAIT_L(0); PG8_MMA(0, 1, At, B1); PG8_BAR;
            PG8_LDA(At, 0, 1); PG8_STAGE(PG8_SA(0, 0), a2, voffA);
            PG8_BAR; PG8_WAIT_L(0); PG8_MMA(1, 0, At, B0); PG8_BAR; PG8_SCHED;
            PG8_STAGE(PG8_SB(0, 1), b2 + hstep, voffB);
            PG8_WAIT_V(6); PG8_BAR; PG8_MMA(1, 1, At, B1); PG8_BAR;
            PG8_LDB(B0, 1, 0); PG8_SCHED; PG8_LDA(At, 1, 0); PG8_STAGE(PG8_SA(0, 1), a2 + hstep, voffA);
            PG8_WAIT_L(8); PG8_BAR; PG8_WAIT_L(0); PG8_MMA(0, 0, At, B0); PG8_BAR; PG8_SCHED;
            PG8_LDB(B1, 1, 1); PG8_STAGE(PG8_SB(1, 0), b3, voffB);
            PG8_BAR; PG8_WAIT_L(0); PG8_MMA(0, 1, At, B1); PG8_BAR;
            PG8_LDA(At, 1, 1); PG8_STAGE(PG8_SA(1, 0), a3, voffA);
            PG8_BAR; PG8_WAIT_L(0); PG8_MMA(1, 0, At, B0); PG8_BAR; PG8_SCHED;
            PG8_STAGE(PG8_SB(1, 1), b3 + hstep, voffB);
            PG8_WAIT_V(6); PG8_BAR; PG8_MMA(1, 1, At, B1); PG8_BAR;
        }
        if constexpr (!Epi::AFTER_DRAIN) { E(acc, cur, wr, wc, fr, fq); S.done(cur); }
        if (!has_next) break;
#pragma unroll
        for (int a = 0; a < 2; ++a)
#pragma unroll
            for (int b = 0; b < 2; ++b)
#pragma unroll
                for (int m = 0; m < 4; ++m)
#pragma unroll
                    for (int n = 0; n < 2; ++n) acc[a][b][m][n] = (f32x4){0.f, 0.f, 0.f, 0.f};
        cur = nxt; cA = nA; cB = nB; ++ui;
    }
    PG8_WAIT_V(0);
    if (wr == 0) PG8_BAR;
    PG8_BAR;
    if constexpr (Epi::AFTER_DRAIN) { E.fused(acc, cur, wr, wc, fr, fq, lds, wid, lane); S.done(cur); }
#undef PG8_SA
#undef PG8_SB
#undef PG8_STAGE
#undef PG8_LDA
#undef PG8_LDB
#undef PG8_MMA
#undef PG8_WAIT_V
#undef PG8_WAIT_L
#undef PG8_BAR
#undef PG8_SCHED
}
}

using pg8::bf16_t; using pg8::bf16x8; using pg8::f32x4; using pg8::u32x4; using pg8::cvt_pk_bf16;
#define LAS PG8_LAS
typedef float f32x16 __attribute__((ext_vector_type(16)));
typedef unsigned u32x2 __attribute__((ext_vector_type(2)));

constexpr int MP = 32768, MS = 256, MT = MP + MS, DM = 1024, N1 = 4096, N3 = 2560;
constexpr float LOG2E = 1.4426950408889634f;
constexpr size_t WS_ACT = 0;
constexpr size_t WS_Y   = WS_ACT + (size_t)MT * DM * 2;
constexpr size_t WS_U   = WS_Y + (size_t)MT * DM * 2;
constexpr size_t WS_W1T = WS_U + (size_t)MT * N1 * 2;
constexpr size_t WS_W2T = WS_W1T + (size_t)N1 * DM * 2;
constexpr size_t WS_W3T = WS_W2T + (size_t)DM * DM * 2;
constexpr size_t WS_W4T = WS_W3T + (size_t)N3 * DM * 2;
constexpr size_t WS_ROPC = WS_W4T + (size_t)DM * DM * 2;
constexpr size_t WS_ROPS = WS_ROPC + 2112 * 32 * 4;
constexpr size_t WS_SSQ = WS_ROPS + 2112 * 32 * 4;
constexpr size_t WS_CTL = WS_SSQ + (size_t)MT * 16 * 4;
constexpr size_t WS_XB = WS_CTL + 4096;
constexpr size_t WS_Y1 = WS_XB + 16384;
constexpr size_t WS_END = WS_Y1 + (size_t)MT * DM * 2;
constexpr size_t O_YP = 0;
constexpr size_t O_YS = O_YP + (size_t)MP * DM;
constexpr size_t O_AKP = O_YS + (size_t)MS * DM;
constexpr size_t O_AVP = O_AKP + (size_t)16 * 512 * 512;
constexpr size_t O_BKP = O_AVP + (size_t)16 * 512 * 512;
constexpr size_t O_BVP = O_BKP + (size_t)MP * 512;
constexpr size_t O_CKP = O_BVP + (size_t)MP * 512;
constexpr size_t O_CVP = O_CKP + (size_t)16 * 128 * 256;
constexpr size_t O_AKS = O_CVP + (size_t)16 * 128 * 256;
constexpr size_t O_AVS = O_AKS + (size_t)256 * 512;
constexpr size_t O_BKS = O_AVS + (size_t)256 * 512;
constexpr size_t O_BVS = O_BKS + (size_t)256 * 512;
constexpr size_t O_CKS = O_BVS + (size_t)256 * 512;
constexpr size_t O_CVS = O_CKS + (size_t)256 * 256;
constexpr size_t O_END = O_CVS + (size_t)256 * 256;

#define CW_QEL(k)  (448 + 16 * (k))
#define CW_BAR(k)  (64 + 16 * (k))
#define CW_SAMP(ph) (320 + 16 * (ph))
struct Params {
    const float* in[18];
    float* out;
    unsigned char* ws;
    int ph_lo, ph_hi;
};

__device__ __forceinline__ float bf_lo(unsigned w) { return __uint_as_float(w << 16); }
__device__ __forceinline__ float bf_hi(unsigned w) { return __uint_as_float(w & 0xffff0000u); }
__device__ __forceinline__ float wave_sum(float v) {
#pragma unroll
    for (int o = 32; o; o >>= 1) v += __shfl_xor(v, o);
    return v;
}
__device__ __forceinline__ int opaque_tid() { int t = threadIdx.x; asm volatile("" : "+v"(t)); return t; }
__device__ __forceinline__ int opaque_bid() { int b = blockIdx.x; asm volatile("" : "+s"(b)); return b; }
__device__ __forceinline__ void block_wait(unsigned* word, unsigned need) {
    if (threadIdx.x == 0) {
        unsigned spins = 0;
        while (__hip_atomic_load(word, __ATOMIC_RELAXED, __HIP_MEMORY_SCOPE_AGENT) < need && ++spins < (1u << 21)) __builtin_amdgcn_s_sleep(1);
        __builtin_amdgcn_fence(__ATOMIC_ACQUIRE, "agent");
        asm volatile("s_waitcnt vmcnt(0)" ::: "memory");
    }
    __syncthreads();
}
__device__ __forceinline__ void wave_wait(unsigned* word, unsigned need) {
    unsigned spins = 0;
    while (__hip_atomic_load(word, __ATOMIC_RELAXED, __HIP_MEMORY_SCOPE_AGENT) < need && ++spins < (1u << 21)) __builtin_amdgcn_s_sleep(1);
    __builtin_amdgcn_fence(__ATOMIC_ACQUIRE, "agent");
    asm volatile("s_waitcnt vmcnt(0)" ::: "memory");
}
__device__ __forceinline__ void block_signal(unsigned* word) {
    asm volatile("s_waitcnt vmcnt(0)" ::: "memory");
    __syncthreads();
    if (threadIdx.x == 0) {
        __builtin_amdgcn_fence(__ATOMIC_RELEASE, "agent");
        asm volatile("s_waitcnt vmcnt(0)" ::: "memory");
        __hip_atomic_fetch_add(word, 1u, __ATOMIC_RELAXED, __HIP_MEMORY_SCOPE_AGENT);
    }
}
__device__ __forceinline__ float fexp2(float x) { return __builtin_amdgcn_exp2f(x); }
__device__ __forceinline__ float flog2(float x) { return __builtin_amdgcn_logf(x); }

struct Epi1 {
    static constexpr bool PERM = true, AFTER_DRAIN = false;
    bf16_t* U; float* out;
    __device__ __forceinline__ void operator()(const f32x4 (&acc)[2][2][4][2], const pg8::Unit& u, int wr, int wc, int fr, int fq) const {
        const int reg = u.pn >> 1;
        const bool isA = (reg == 1 || reg == 2), isB = (reg == 5 || reg == 6);
        const int cin = (u.pn & 1) * 256 + wc * 32 + 8 * fq;
        const size_t so = reg == 1 ? O_AKS : reg == 2 ? O_AVS : reg == 5 ? O_BKS : O_BVS;
#pragma unroll
        for (int ai = 0; ai < 2; ++ai)
#pragma unroll
            for (int m = 0; m < 4; ++m) {
                const int row = u.pm * 256 + ai * 128 + wr * 64 + m * 16 + fr;
                bf16_t* up = U + (size_t)row * N1 + u.pn * 256 + wc * 32 + 8 * fq;
                float* fo = nullptr;
                if ((isA || isB) && row >= MP) fo = out + so + (size_t)(row - MP) * 512;
#pragma unroll
                for (int bj = 0; bj < 2; ++bj) {
                    const f32x4 v0 = acc[ai][bj][m][0], v1 = acc[ai][bj][m][1];
                    u32x4 pk; pk[0] = cvt_pk_bf16(v0[0], v0[1]); pk[1] = cvt_pk_bf16(v0[2], v0[3]); pk[2] = cvt_pk_bf16(v1[0], v1[1]); pk[3] = cvt_pk_bf16(v1[2], v1[3]);
                    *(u32x4*)(up + bj * 128) = pk;
                    if (fo) { *(f32x4*)(fo + cin + bj * 128) = v0; *(f32x4*)(fo + cin + bj * 128 + 4) = v1; }
                }
            }
    }
};
struct Epi3 {
    static constexpr bool PERM = true, AFTER_DRAIN = false;
    bf16_t* U; float* out; const float* ropc; const float* rops;
    __device__ __forceinline__ void operator()(const f32x4 (&acc)[2][2][4][2], const pg8::Unit& u, int wr, int wc, int fr, int fq) const {
        const int pn = u.pn;
        const bool rope = pn <= 4, kv = (pn == 4 || pn == 5);
        const int d8 = 8 * fq;
#pragma unroll
        for (int ai = 0; ai < 2; ++ai)
#pragma unroll
            for (int m = 0; m < 4; ++m) {
                const int row = u.pm * 256 + ai * 128 + wr * 64 + m * 16 + fr;
                bf16_t* ur = U + (size_t)row * N3;
                float* fo = nullptr;
                if (kv) {
                    if (row >= MP) fo = out + (pn == 4 ? O_CKS : O_CVS) + (size_t)(row - MP) * 256;
                    else { const int s = row & 2047; if (s >= 1920) fo = out + (pn == 4 ? O_CKP : O_CVP) + ((size_t)(row >> 11) * 128 + (s - 1920)) * 256; }
                }
                if (rope) {
                    const int pos = row < MP ? (row & 2047) : 2048 + ((row - MP) & 31);
                    const f32x4 ca = *(const f32x4*)(ropc + pos * 32 + d8), cb = *(const f32x4*)(ropc + pos * 32 + d8 + 4);
                    const f32x4 sa = *(const f32x4*)(rops + pos * 32 + d8), sb = *(const f32x4*)(rops + pos * 32 + d8 + 4);
                    const int hb = pn * 256 + wc * 64;
                    const f32x4 x1a = acc[ai][0][m][0], x1b = acc[ai][0][m][1], x2a = acc[ai][1][m][0], x2b = acc[ai][1][m][1];
                    const f32x4 o1a = x1a * ca - x2a * sa, o1b = x1b * cb - x2b * sb, o2a = x2a * ca + x1a * sa, o2b = x2b * cb + x1b * sb;
                    u32x4 p1, p2;
                    p1[0] = cvt_pk_bf16(o1a[0], o1a[1]); p1[1] = cvt_pk_bf16(o1a[2], o1a[3]); p1[2] = cvt_pk_bf16(o1b[0], o1b[1]); p1[3] = cvt_pk_bf16(o1b[2], o1b[3]);
                    p2[0] = cvt_pk_bf16(o2a[0], o2a[1]); p2[1] = cvt_pk_bf16(o2a[2], o2a[3]); p2[2] = cvt_pk_bf16(o2b[0], o2b[1]); p2[3] = cvt_pk_bf16(o2b[2], o2b[3]);
                    *(u32x4*)(ur + hb + d8) = p1; *(u32x4*)(ur + hb + 32 + d8) = p2;
                    if (fo) { float* f1 = fo + (hb - 1024) + d8; *(f32x4*)f1 = o1a; *(f32x4*)(f1 + 4) = o1b; *(f32x4*)(f1 + 32) = o2a; *(f32x4*)(f1 + 36) = o2b; }
                } else {
#pragma unroll
                    for (int bj = 0; bj < 2; ++bj) {
                        const int col = pn * 256 + bj * 128 + wc * 32 + 8 * fq;
                        const f32x4 v0 = acc[ai][bj][m][0], v1 = acc[ai][bj][m][1];
                        u32x4 pk; pk[0] = cvt_pk_bf16(v0[0], v0[1]); pk[1] = cvt_pk_bf16(v0[2], v0[3]); pk[2] = cvt_pk_bf16(v1[0], v1[1]); pk[3] = cvt_pk_bf16(v1[2], v1[3]);
                        *(u32x4*)(ur + col) = pk;
                        if (fo) { *(f32x4*)(fo + (col - 1280)) = v0; *(f32x4*)(fo + (col - 1280) + 4) = v1; }
                    }
                }
            }
    }
};
struct Epi2 {
    static constexpr bool PERM = true, AFTER_DRAIN = false;
    bf16_t* Y; float* ssq;
    __device__ __forceinline__ void operator()(const f32x4 (&acc)[2][2][4][2], const pg8::Unit& u, int wr, int wc, int fr, int fq) const {
#pragma unroll
        for (int ai = 0; ai < 2; ++ai)
#pragma unroll
            for (int m = 0; m < 4; ++m) {
                const int row = u.pm * 256 + ai * 128 + wr * 64 + m * 16 + fr;
                bf16_t* yr = Y + (size_t)row * DM + u.pn * 256 + wc * 32 + 8 * fq;
                float ss = 0.f;
#pragma unroll
                for (int bj = 0; bj < 2; ++bj) {
                    const f32x4 v0 = acc[ai][bj][m][0], v1 = acc[ai][bj][m][1];
                    u32x4 pk; pk[0] = cvt_pk_bf16(v0[0], v0[1]); pk[1] = cvt_pk_bf16(v0[2], v0[3]); pk[2] = cvt_pk_bf16(v1[0], v1[1]); pk[3] = cvt_pk_bf16(v1[2], v1[3]);
                    *(u32x4*)(yr + bj * 128) = pk;
                    ss += v0[0] * v0[0] + v0[1] * v0[1] + v0[2] * v0[2] + v0[3] * v0[3] + v1[0] * v1[0] + v1[1] * v1[1] + v1[2] * v1[2] + v1[3] * v1[3];
                }
                ss += __shfl_xor(ss, 16); ss += __shfl_xor(ss, 32);
                if (fq == 0) ssq[(size_t)row * 16 + u.pn * 4 + wc] = ss;
            }
    }
};

__device__ __forceinline__ void store_bf16x4(bf16_t* dst, f32x4 v) { u32x2 pk; pk[0] = cvt_pk_bf16(v[0], v[1]); pk[1] = cvt_pk_bf16(v[2], v[3]); *(u32x2*)dst = pk; }
__device__ __forceinline__ void store_bf16x8(bf16_t* dst, f32x4 a, f32x4 b) { u32x4 pk; pk[0] = cvt_pk_bf16(a[0], a[1]); pk[1] = cvt_pk_bf16(a[2], a[3]); pk[2] = cvt_pk_bf16(b[0], b[1]); pk[3] = cvt_pk_bf16(b[2], b[3]); *(u32x4*)dst = pk; }
__device__ __forceinline__ f32x4 load_bf16x4(const bf16_t* src) { const u32x2 r = *(const u32x2*)src; f32x4 v; v[0] = bf_lo(r[0]); v[1] = bf_hi(r[0]); v[2] = bf_lo(r[1]); v[3] = bf_hi(r[1]); return v; }
__device__ __forceinline__ const float* xrow(const Params& p, int row) { return row < MP ? p.in[0] + (size_t)row * DM : p.in[1] + (size_t)(row - MP) * DM; }
__device__ __forceinline__ float* yrow(const Params& p, int row) { return p.out + (row < MP ? O_YP + (size_t)row * DM : O_YS + (size_t)(row - MP) * DM); }

template <int NR>
__device__ __forceinline__ void prenorm_rows(const Params& p, int row0, int lane) {
    const float* g = p.in[8];
    bf16_t* xn = (bf16_t*)(p.ws + WS_ACT);
    f32x4 v[NR][4];
#pragma unroll
    for (int r = 0; r < NR; ++r) {
        const float* xr = xrow(p, row0 + r);
#pragma unroll
        for (int i = 0; i < 4; ++i) v[r][i] = *(const f32x4*)(xr + ((i >> 1) * 512 + lane * 8 + (i & 1) * 4));
    }
#pragma unroll
    for (int r = 0; r < NR; ++r) {
        float ss = 0.f;
#pragma unroll
        for (int i = 0; i < 4; ++i) ss += v[r][i][0] * v[r][i][0] + v[r][i][1] * v[r][i][1] + v[r][i][2] * v[r][i][2] + v[r][i][3] * v[r][i][3];
        const float rs = rsqrtf(wave_sum(ss) * (1.0f / 1024.0f) + 1e-6f);
#pragma unroll
        for (int ip = 0; ip < 2; ++ip) { const int c = ip * 512 + lane * 8; const f32x4 g0 = *(const f32x4*)(g + c), g1 = *(const f32x4*)(g + c + 4); store_bf16x8(xn + (size_t)(row0 + r) * DM + c, v[r][2 * ip] * rs * g0, v[r][2 * ip + 1] * rs * g1); }
    }
}

__device__ __forceinline__ void phase_prep(const Params& p, LAS unsigned char* lds) {
    const int tid = opaque_tid(), wid = tid >> 6, lane = tid & 63, bid = opaque_bid(), nb = gridDim.x;
    unsigned char* ws = p.ws;
    if (bid == 0) for (int i = tid; i < 1024 + 4096; i += 512) ((unsigned*)(ws + WS_CTL))[i] = 0u;
    float* ropc = (float*)(ws + WS_ROPC); float* rops = (float*)(ws + WS_ROPS);
    for (int i = bid * 512 + tid; i < 2112 * 32; i += nb * 512) {
        const int pos = i >> 5, d = i & 31;
        const float inv = exp2f(-(float)d * (2.0f / 64.0f) * 13.287712379549449f);
        const float ang = (float)pos * inv;
        const double x = (double)ang, n = rint(x * 0.15915494309189535), r = x - n * 6.283185307179586;
        const float rf = (float)r;
        ropc[i] = __cosf(rf); rops[i] = __sinf(rf);
    }
    LAS float* tl = (LAS float*)lds;
    const int gw = wid * nb + bid, nw = 8 * nb;
    const int nq = (544 - bid + nb - 1) / nb, ng = (MP / 4 - gw + nw - 1) / nw;
    for (int itn = 0; itn < (nq > ng ? nq : ng); ++itn) {
        const int q4 = bid + itn * nb; const bool wq = q4 < 544;
        f32x4 la[4], lb[4];
        if (wq) {
#pragma unroll
            for (int u = 0; u < 4; ++u) {
                const int t = 4 * q4 + u;
                const float* W; int N, tt;
                if (t < 1024) { W = p.in[9]; N = N1; tt = t; }
                else if (t < 1280) { W = p.in[10]; N = DM; tt = t - 1024; }
                else if (t < 1920) { W = p.in[14]; N = N3; tt = t - 1280; }
                else { W = p.in[16]; N = DM; tt = t - 1920; }
                const int n0 = (tt >> 4) * 64, k0 = (tt & 15) * 64;
                const int k = tid >> 3, c = (tid & 7) * 8;
                int scol = n0 + c;
                if (t >= 1280 && t < 1920 && scol < 1280) { const int sl = scol & 255; scol = (scol & ~255) + ((sl >> 5) & 3) * 64 + (sl >> 7) * 32 + (sl & 31); }
                const float* src = W + (size_t)(k0 + k) * N + scol;
                la[u] = *(const f32x4*)src; lb[u] = *(const f32x4*)(src + 4);
            }
        }
        { const int gi = gw + itn * nw; if (gi < MP / 4) prenorm_rows<4>(p, 4 * gi, lane); }
        if (wq) {
#pragma unroll
            for (int u = 0; u < 4; ++u) {
                const int k = tid >> 3, c = (tid & 7) * 8;
#pragma unroll
                for (int j = 0; j < 4; ++j) { tl[u * 4160 + k * 65 + c + j] = la[u][j]; tl[u * 4160 + k * 65 + c + 4 + j] = lb[u][j]; }
            }
            __syncthreads();
#pragma unroll
            for (int u = 0; u < 4; ++u) {
                const int t = 4 * q4 + u;
                bf16_t* WT; int tt; bool perm = false;
                if (t < 1024) { WT = (bf16_t*)(ws + WS_W1T); tt = t; }
                else if (t < 1280) { WT = (bf16_t*)(ws + WS_W2T); tt = t - 1024; }
                else if (t < 1920) { WT = (bf16_t*)(ws + WS_W3T); tt = t - 1280; perm = true; }
                else { WT = (bf16_t*)(ws + WS_W4T); tt = t - 1920; }
                const int n0 = (tt >> 4) * 64, k0 = (tt & 15) * 64;
                const int slot = tid >> 3, kc = (tid & 7) * 8;
                int ncol = slot;
                (void)perm;
                float v[8];
#pragma unroll
                for (int j = 0; j < 8; ++j) v[j] = tl[u * 4160 + (kc + j) * 65 + ncol];
                u32x4 pk; pk[0] = cvt_pk_bf16(v[0], v[1]); pk[1] = cvt_pk_bf16(v[2], v[3]); pk[2] = cvt_pk_bf16(v[4], v[5]); pk[3] = cvt_pk_bf16(v[6], v[7]);
                *(u32x4*)(WT + (size_t)(n0 + slot) * DM + k0 + kc) = pk;
            }
            __syncthreads();
        }
    }
    for (int r = MP + gw; r < MT; r += nw) prenorm_rows<1>(p, r, lane);
}

__device__ __forceinline__ float ssq_total(const float* ssq, int row) {
    const f32x4* sp = (const f32x4*)(ssq + (size_t)row * 16);
    const f32x4 s0 = sp[0], s1 = sp[1], s2 = sp[2], s3 = sp[3];
    return (s0[0] + s0[1] + s0[2] + s0[3]) + (s1[0] + s1[1] + s1[2] + s1[3]) + (s2[0] + s2[1] + s2[2] + s2[3]) + (s3[0] + s3[1] + s3[2] + s3[3]);
}
template <int NR>
__device__ __forceinline__ void mid_rows(const Params& p, int row0, int lane) {
    const bf16_t* y = (const bf16_t*)(p.ws + WS_Y); const float* ssq = (const float*)(p.ws + WS_SSQ); bf16_t* xn = (bf16_t*)(p.ws + WS_ACT);
    const float* gpost = p.in[11]; const float* gpre = p.in[13];
    bf16_t* y1 = (bf16_t*)(p.ws + WS_Y1);
    f32x4 v[NR][4], yv[NR][4]; float st[NR];
#pragma unroll
    for (int r = 0; r < NR; ++r) {
        const float* xr = xrow(p, row0 + r);
        st[r] = ssq_total(ssq, row0 + r);
#pragma unroll
        for (int i = 0; i < 4; ++i) { const int c = ((i >> 1) * 512 + lane * 8 + (i & 1) * 4); v[r][i] = *(const f32x4*)(xr + c); yv[r][i] = load_bf16x4(y + (size_t)(row0 + r) * DM + c); }
    }
    float ss[NR];
#pragma unroll
    for (int r = 0; r < NR; ++r) {
        const float rs = rsqrtf(st[r] * (1.0f / 1024.0f) + 1e-6f);
        ss[r] = 0.f;
#pragma unroll
        for (int i = 0; i < 4; ++i) {
            const int c = ((i >> 1) * 512 + lane * 8 + (i & 1) * 4);
            const f32x4 gp = *(const f32x4*)(gpost + c);
            v[r][i] = v[r][i] + yv[r][i] * rs * gp;
            ss[r] += v[r][i][0] * v[r][i][0] + v[r][i][1] * v[r][i][1] + v[r][i][2] * v[r][i][2] + v[r][i][3] * v[r][i][3];
        }
    }
#pragma unroll
    for (int r = 0; r < NR; ++r) {
#pragma unroll
        for (int ip = 0; ip < 2; ++ip) store_bf16x8(y1 + (size_t)(row0 + r) * DM + ip * 512 + lane * 8, v[r][2 * ip], v[r][2 * ip + 1]);
        const float rs2 = rsqrtf(wave_sum(ss[r]) * (1.0f / 1024.0f) + 1e-6f);
#pragma unroll
        for (int ip = 0; ip < 2; ++ip) { const int c = ip * 512 + lane * 8; const f32x4 g0 = *(const f32x4*)(gpre + c), g1 = *(const f32x4*)(gpre + c + 4); store_bf16x8(xn + (size_t)(row0 + r) * DM + c, v[r][2 * ip] * rs2 * g0, v[r][2 * ip + 1] * rs2 * g1); }
    }
}
__device__ __forceinline__ void phase_mid(const Params& p) {
    const int tid = opaque_tid(), wid = tid >> 6, lane = tid & 63, bid = opaque_bid(), nb = gridDim.x;
    unsigned* cw = (unsigned*)(p.ws + WS_CTL);
    constexpr int NSB = DM / 256;
    if (bid < NSB) {
        block_wait(cw + CW_SAMP(3), NSB);
        for (int r = MP + bid * 8 + wid; r < MT; r += NSB * 8) mid_rows<1>(p, r, lane);
    } else {
        const int w = wid * (nb - NSB) + (bid - NSB), nw = 8 * (nb - NSB);
        const int ngrp = (MP / 4) / nw * nw;
        for (int gi = w; gi < ngrp; gi += nw) mid_rows<4>(p, 4 * gi, lane);
        for (int r = 4 * ngrp + w; r < MP; r += nw) mid_rows<1>(p, r, lane);
    }
}
template <int NR>
__device__ __forceinline__ void fin_rows(const Params& p, int row0, int lane) {
    const bf16_t* y = (const bf16_t*)(p.ws + WS_Y); const float* ssq = (const float*)(p.ws + WS_SSQ);
    const float* gpost = p.in[17];
    const bf16_t* y1 = (const bf16_t*)(p.ws + WS_Y1);
    f32x4 v[NR][4], yv[NR][4]; float st[NR];
#pragma unroll
    for (int r = 0; r < NR; ++r) {
        st[r] = ssq_total(ssq, row0 + r);
#pragma unroll
        for (int i = 0; i < 4; ++i) { const int c = ((i >> 1) * 512 + lane * 8 + (i & 1) * 4); v[r][i] = load_bf16x4(y1 + (size_t)(row0 + r) * DM + c); yv[r][i] = load_bf16x4(y + (size_t)(row0 + r) * DM + c); }
    }
#pragma unroll
    for (int r = 0; r < NR; ++r) {
        const float rs = rsqrtf(st[r] * (1.0f / 1024.0f) + 1e-6f);
        float* o = yrow(p, row0 + r);
#pragma unroll
        for (int i = 0; i < 4; ++i) { const int c = ((i >> 1) * 512 + lane * 8 + (i & 1) * 4); const f32x4 gp = *(const f32x4*)(gpost + c); *(f32x4*)(o + c) = v[r][i] + yv[r][i] * rs * gp; }
    }
}
__device__ __forceinline__ void phase_fin(const Params& p) {
    const int tid = opaque_tid(), wid = tid >> 6, lane = tid & 63, bid = opaque_bid(), nb = gridDim.x;
    unsigned* cw = (unsigned*)(p.ws + WS_CTL);
    constexpr int NSB = DM / 256;
    if (bid < NSB) {
        block_wait(cw + CW_SAMP(7), NSB);
        for (int r = MP + bid * 8 + wid; r < MT; r += NSB * 8) fin_rows<1>(p, r, lane);
    } else {
        const int w = wid * (nb - NSB) + (bid - NSB), nw = 8 * (nb - NSB);
        const int ngrp = (MP / 4) / nw * nw;
        for (int gi = w; gi < ngrp; gi += nw) fin_rows<4>(p, 4 * gi, lane);
        for (int r = 4 * ngrp + w; r < MP; r += nw) fin_rows<1>(p, r, lane);
    }
}

constexpr int KST = 144, VST = 192;
constexpr int L_K = 0, L_V = 4 * 64 * KST, L_BIAS = L_V + 4 * 64 * VST, L_IT = L_BIAS + 1056;

struct AttnItem {
    int kind;
    int t_lo, t_hi;
    int kbase;
    int nkeys;
    int L;
    const float* ck; const float* cv; int cstride;
    const bf16_t* uk; const bf16_t* uv; int ustride;
    const float* bias;
    float* outk; float* outv; int own_lo, own_hi;
    int active; int qpos0; float sink2;
    const bf16_t* q; const bf16_t* g; bf16_t* o;
};

struct TileRegs { u32x4 a, b, c, d; };

template <int KIND, bool PRE = false>
__device__ __forceinline__ void attn_run(const AttnItem& it, LAS unsigned char* lds, int tid, int lane, unsigned* qctr, int& pre) {
    const int l32 = lane & 31, hh = lane >> 5;
    bf16x8 qf[4];
    u32x4 gv[4];
    if (it.active) {
        const bf16_t* qp = it.q + (size_t)l32 * it.ustride + 8 * hh;
        u32x4 raw[4];
#pragma unroll
        for (int kk = 0; kk < 4; ++kk) raw[kk] = *(const u32x4*)(qp + 16 * kk);
        const bf16_t* gp = it.g + (size_t)l32 * it.ustride + 8 * hh;
#pragma unroll
        for (int i = 0; i < 4; ++i) gv[i] = *(const u32x4*)(gp + (i >> 1) * 32 + (i & 1) * 16);
#pragma unroll
        for (int kk = 0; kk < 4; ++kk) {
            u32x4 sc;
#pragma unroll
            for (int j = 0; j < 4; ++j) sc[j] = cvt_pk_bf16(bf_lo(raw[kk][j]) * 0.125f, bf_hi(raw[kk][j]) * 0.125f);
            qf[kk] = __builtin_bit_cast(bf16x8, sc);
        }
    }
    if (KIND == 0) { LAS float* bl = (LAS float*)(lds + L_BIAS); for (int i = tid; i < 257; i += 512) bl[i] = it.bias[i] * LOG2E; }
    const LAS float* biasL = (const LAS float*)(lds + L_BIAS);

    f32x16 o0, o1;
#pragma unroll
    for (int i = 0; i < 16; ++i) { o0[i] = 0.f; o1[i] = 0.f; }
    float mrun = (KIND == 2) ? it.sink2 : -INFINITY;
    float lrun = (KIND == 2 && hh == 0) ? 1.0f : 0.0f;
    float carry = 1.0f;
    bool wdone = false;

    const int lkey = tid >> 3, lc = tid & 7;
    auto issue = [&](int t, TileRegs& R) {
        const int key = 64 * t + lkey;
        const bool f32src = 64 * t < it.L;
        const char* kp; const char* vp;
        if (f32src) { kp = (const char*)(it.ck + (size_t)key * it.cstride + 8 * lc); vp = (const char*)(it.cv + (size_t)key * it.cstride + 8 * lc); }
        else { const int kk = (key < it.nkeys ? key : it.nkeys - 1) - it.L; kp = (const char*)(it.uk + (size_t)kk * it.ustride + 8 * lc); vp = (const char*)(it.uv + (size_t)kk * it.ustride + 8 * lc); }
        R.a = *(const u32x4*)kp; R.b = *(const u32x4*)vp;
        if (f32src) { R.c = *(const u32x4*)(kp + 16); R.d = *(const u32x4*)(vp + 16); }
    };
    auto commit = [&](int t, int buf, const TileRegs& R) {
        u32x4 k16, v16;
        if (64 * t < it.L) {
            const f32x4 ka = __builtin_bit_cast(f32x4, R.a), kb2 = __builtin_bit_cast(f32x4, R.c), va2 = __builtin_bit_cast(f32x4, R.b), vb2 = __builtin_bit_cast(f32x4, R.d);
            k16[0] = cvt_pk_bf16(ka[0], ka[1]); k16[1] = cvt_pk_bf16(ka[2], ka[3]); k16[2] = cvt_pk_bf16(kb2[0], kb2[1]); k16[3] = cvt_pk_bf16(kb2[2], kb2[3]);
            v16[0] = cvt_pk_bf16(va2[0], va2[1]); v16[1] = cvt_pk_bf16(va2[2], va2[3]); v16[2] = cvt_pk_bf16(vb2[0], vb2[1]); v16[3] = cvt_pk_bf16(vb2[2], vb2[3]);
        } else {
            k16 = R.a; v16 = R.b;
            if (t >= it.own_lo && t < it.own_hi) {
                float* ok = it.outk + (size_t)(64 * t + lkey) * 512 + 8 * lc; float* ov = it.outv + (size_t)(64 * t + lkey) * 512 + 8 * lc;
                f32x4 a, b2, c, d2;
                a[0] = bf_lo(k16[0]); a[1] = bf_hi(k16[0]); a[2] = bf_lo(k16[1]); a[3] = bf_hi(k16[1]); b2[0] = bf_lo(k16[2]); b2[1] = bf_hi(k16[2]); b2[2] = bf_lo(k16[3]); b2[3] = bf_hi(k16[3]);
                c[0] = bf_lo(v16[0]); c[1] = bf_hi(v16[0]); c[2] = bf_lo(v16[1]); c[3] = bf_hi(v16[1]); d2[0] = bf_lo(v16[2]); d2[1] = bf_hi(v16[2]); d2[2] = bf_lo(v16[3]); d2[3] = bf_hi(v16[3]);
                *(f32x4*)ok = a; *(f32x4*)(ok + 4) = b2; *(f32x4*)ov = c; *(f32x4*)(ov + 4) = d2;
            }
        }
        *(LAS u32x4*)(lds + L_K + buf * (64 * KST) + lkey * KST + lc * 16) = k16;
        *(LAS u32x4*)(lds + L_V + buf * (64 * VST) + lkey * VST + lc * 16) = v16;
    };
    const unsigned vlane = (unsigned)(size_t)(lds + L_V) + (unsigned)((((lane & 15) >> 2) + 4 * hh) * VST + (16 * ((lane >> 4) & 1) + 4 * (lane & 3)) * 2);

    auto sb_sub = [&](const f32x16& s, int kps, float (&pv)[16]) {
        const bool diag = (kps + 31 >= it.qpos0);
        const int lim = it.qpos0 + l32 - kps - 4 * hh;
        float om[16], sg[16];
#pragma unroll
        for (int i = 0; i < 16; ++i) {
            const float u = fexp2(fminf(s[i] * LOG2E, 80.0f));
            const float r = __builtin_amdgcn_rcpf(1.0f + u);
            om[i] = r; sg[i] = u * r;
        }
        if (diag) {
#pragma unroll
            for (int i = 0; i < 16; ++i) { const bool valid = (8 * (i >> 2) + (i & 3) < lim); om[i] = valid ? om[i] : 1.0f; sg[i] = valid ? sg[i] : 0.0f; }
        }
        float e[16], G[4], Go[4];
#pragma unroll
        for (int g = 0; g < 4; ++g) {
            e[4 * g + 3] = 1.0f; e[4 * g + 2] = om[4 * g + 3]; e[4 * g + 1] = e[4 * g + 2] * om[4 * g + 2]; e[4 * g] = e[4 * g + 1] * om[4 * g + 1];
            G[g] = e[4 * g] * om[4 * g];
        }
#pragma unroll
        for (int g = 0; g < 4; ++g) Go[g] = __shfl_xor(G[g], 32);
        float S[4];
        S[3] = 1.0f; S[2] = G[3] * Go[3]; S[1] = S[2] * (G[2] * Go[2]); S[0] = S[1] * (G[1] * Go[1]);
        const float total = S[0] * (G[0] * Go[0]);
#pragma unroll
        for (int g = 0; g < 4; ++g) {
            const float bl = carry * S[g] * (hh == 0 ? Go[g] : 1.0f);
#pragma unroll
            for (int j = 0; j < 4; ++j) pv[4 * g + j] = sg[4 * g + j] * (bl * e[4 * g + j]);
        }
        carry *= total;
    };
    auto compute = [&](int t, int buf) {
        if (!it.active || wdone) return;
        const int ks0 = 64 * t, kp0 = it.kbase + ks0;
        bool use, v1;
        if (KIND == 1) { use = kp0 < it.qpos0 + 31; v1 = kp0 + 32 < it.qpos0 + 31; }
        else { const int kc = kp0 >> 6, qc = it.qpos0 >> 6; use = (kc <= qc) && (kc >= qc - (KIND == 0 ? 8 : 2)); v1 = ks0 + 32 < it.nkeys; }
        if (!use) return;
        const LAS unsigned char* kb = lds + L_K + buf * (64 * KST) + l32 * KST + 16 * hh;
        bf16x8 kf0[4], kf1[4];
#pragma unroll
        for (int kk = 0; kk < 4; ++kk) { kf0[kk] = *(const LAS bf16x8*)(kb + kk * 32); kf1[kk] = *(const LAS bf16x8*)(kb + 32 * KST + kk * 32); }
        f32x16 s0, s1;
#pragma unroll
        for (int i = 0; i < 16; ++i) { s0[i] = 0.f; s1[i] = 0.f; }
#pragma unroll
        for (int kk = 0; kk < 4; ++kk) {
            s0 = __builtin_amdgcn_mfma_f32_32x32x16_bf16(kf0[kk], qf[kk], s0, 0, 0, 0);
            s1 = __builtin_amdgcn_mfma_f32_32x32x16_bf16(kf1[kk], qf[kk], s1, 0, 0, 0);
        }
        float pa[16], pb[16];
        if (KIND == 1) {
            if (v1) sb_sub(s1, kp0 + 32, pb);
            else {
#pragma unroll
                for (int i = 0; i < 16; ++i) pb[i] = 0.f;
            }
            sb_sub(s0, kp0, pa);
            wdone = __all(carry == 0.0f) != 0;
        } else {
            float sa[16], sb[16];
            if (KIND == 0) {
                if (kp0 + 63 + 128 <= it.qpos0) {
                    const float b256 = biasL[256];
#pragma unroll
                    for (int i = 0; i < 16; ++i) { sa[i] = s0[i] * LOG2E + b256; sb[i] = s1[i] * LOG2E + b256; }
                } else {
                    const int rel0 = it.qpos0 + l32 - kp0 - 4 * hh + 128;
#pragma unroll
                    for (int i = 0; i < 16; ++i) {
                        int r = rel0 - (8 * (i >> 2) + (i & 3));
                        int r1 = r - 32;
                        r = r < 0 ? 0 : (r > 256 ? 256 : r);
                        r1 = r1 < 0 ? 0 : (r1 > 256 ? 256 : r1);
                        sa[i] = s0[i] * LOG2E + biasL[r];
                        sb[i] = s1[i] * LOG2E + biasL[r1];
                    }
                }
            } else {
#pragma unroll
                for (int i = 0; i < 16; ++i) { sa[i] = s0[i] * LOG2E; sb[i] = s1[i] * LOG2E; }
            }
            if (!v1) {
#pragma unroll
                for (int i = 0; i < 16; ++i) sb[i] = -INFINITY;
            }
            float mx = fmaxf(sa[0], sb[0]);
#pragma unroll
            for (int i = 1; i < 16; ++i) mx = fmaxf(mx, fmaxf(sa[i], sb[i]));
            mx = fmaxf(mx, __shfl_xor(mx, 32));
            const float mnew = fmaxf(mrun, mx);
            const float alpha = fexp2(mrun - mnew);
            float rsum = 0.f;
#pragma unroll
            for (int i = 0; i < 16; ++i) { pa[i] = fexp2(sa[i] - mnew); pb[i] = fexp2(sb[i] - mnew); rsum += pa[i] + pb[i]; }
            lrun = lrun * alpha + rsum; mrun = mnew;
            if (!__all(alpha == 1.0f)) {
#pragma unroll
                for (int i = 0; i < 16; ++i) { o0[i] *= alpha; o1[i] *= alpha; }
            }
        }
        {
            const unsigned va = vlane + (unsigned)(buf * 64 * VST);
            u32x2 vf[16];
            asm volatile("ds_read_b64_tr_b16 %0, %16 offset:0\n\tds_read_b64_tr_b16 %1, %16 offset:1536\n\tds_read_b64_tr_b16 %2, %16 offset:64\n\tds_read_b64_tr_b16 %3, %16 offset:1600\n\tds_read_b64_tr_b16 %4, %16 offset:3072\n\tds_read_b64_tr_b16 %5, %16 offset:4608\n\tds_read_b64_tr_b16 %6, %16 offset:3136\n\tds_read_b64_tr_b16 %7, %16 offset:4672\n\tds_read_b64_tr_b16 %8, %16 offset:6144\n\tds_read_b64_tr_b16 %9, %16 offset:7680\n\tds_read_b64_tr_b16 %10, %16 offset:6208\n\tds_read_b64_tr_b16 %11, %16 offset:7744\n\tds_read_b64_tr_b16 %12, %16 offset:9216\n\tds_read_b64_tr_b16 %13, %16 offset:10752\n\tds_read_b64_tr_b16 %14, %16 offset:9280\n\tds_read_b64_tr_b16 %15, %16 offset:10816\n\ts_waitcnt lgkmcnt(0)"
                         : "=&v"(vf[0]), "=&v"(vf[1]), "=&v"(vf[2]), "=&v"(vf[3]), "=&v"(vf[4]), "=&v"(vf[5]), "=&v"(vf[6]), "=&v"(vf[7]), "=&v"(vf[8]), "=&v"(vf[9]), "=&v"(vf[10]), "=&v"(vf[11]), "=&v"(vf[12]), "=&v"(vf[13]), "=&v"(vf[14]), "=&v"(vf[15]) : "v"(va) : "memory");
#pragma unroll
            for (int sub = 0; sub < 2; ++sub) {
                if (sub == 1 && !v1) break;
#pragma unroll
                for (int G2 = 0; G2 < 2; ++G2) {
                    u32x4 pk;
#pragma unroll
                    for (int j = 0; j < 4; ++j) pk[j] = sub == 0 ? cvt_pk_bf16(pa[8 * G2 + 2 * j], pa[8 * G2 + 2 * j + 1]) : cvt_pk_bf16(pb[8 * G2 + 2 * j], pb[8 * G2 + 2 * j + 1]);
                    const bf16x8 pf = __builtin_bit_cast(bf16x8, pk);
                    const int n = 4 * (2 * sub + G2);
                    u32x4 vA, vC; vA[0] = vf[n][0]; vA[1] = vf[n][1]; vA[2] = vf[n + 1][0]; vA[3] = vf[n + 1][1]; vC[0] = vf[n + 2][0]; vC[1] = vf[n + 2][1]; vC[2] = vf[n + 3][0]; vC[3] = vf[n + 3][1];
                    o0 = __builtin_amdgcn_mfma_f32_32x32x16_bf16(__builtin_bit_cast(bf16x8, vA), pf, o0, 0, 0, 0);
                    o1 = __builtin_amdgcn_mfma_f32_32x32x16_bf16(__builtin_bit_cast(bf16x8, vC), pf, o1, 0, 0, 0);
                }
            }
        }
    };
    auto vote = [&]() -> bool {
        if (KIND == 1) return __syncthreads_and((wdone || !it.active) ? 1 : 0) != 0;
        __syncthreads(); return false;
    };

    TileRegs R0, R1;
    int t = it.t_hi - 1, buf = 0;
    bool first = true;
    auto clampt = [&](int tt) { return tt >= it.t_lo ? tt : it.t_lo; };
    if (!PRE) { issue(t, R0); issue(clampt(t - 1), R1); }
    if (PRE) {
        for (int tt = it.t_hi - 1; tt >= it.t_lo; --tt) compute(tt, tt & 3);
    } else
    for (;;) {
        commit(t, 2 * buf, R0);
        commit(clampt(t - 1), 2 * buf + 1, R1);
        if (vote()) break;
        if (first) { first = false; if (tid == 0) pre = (int)atomicAdd(qctr, 1u); }
        issue(clampt(t - 2), R0);
        issue(clampt(t - 3), R1);
        compute(t, 2 * buf);
        if (t - 1 >= it.t_lo) compute(t - 1, 2 * buf + 1);
        buf ^= 1; t -= 2;
        if (t < it.t_lo) break;
    }
    if (it.active) {
        float inv = 1.0f;
        if (KIND != 1) { const float lt = lrun + __shfl_xor(lrun, 32); inv = 1.0f / lt; }
        bf16_t* op = it.o + (size_t)l32 * DM + 8 * hh;
#pragma unroll
        for (int db = 0; db < 2; ++db)
#pragma unroll
            for (int k = 0; k < 2; ++k) {
                float lo[4], hi[4];
#pragma unroll
                for (int j = 0; j < 4; ++j) {
                    const float a = (db == 0 ? o0[8 * k + j] : o1[8 * k + j]) * inv;
                    const float b = (db == 0 ? o0[8 * k + 4 + j] : o1[8 * k + 4 + j]) * inv;
                    const auto sw = __builtin_amdgcn_permlane32_swap(__float_as_uint(a), __float_as_uint(b), false, false);
                    lo[j] = __uint_as_float(sw[0]); hi[j] = __uint_as_float(sw[1]);
                }
                const u32x4 gr = gv[2 * db + k];
                float gq[8];
#pragma unroll
                for (int j = 0; j < 4; ++j) { gq[2 * j] = bf_lo(gr[j]); gq[2 * j + 1] = bf_hi(gr[j]); }
                float r[8];
#pragma unroll
                for (int j = 0; j < 4; ++j) { r[j] = lo[j] * gq[j] / (1.0f + __expf(-gq[j])); r[4 + j] = hi[j] * gq[4 + j] / (1.0f + __expf(-gq[4 + j])); }
                u32x4 pk; pk[0] = cvt_pk_bf16(r[0], r[1]); pk[1] = cvt_pk_bf16(r[2], r[3]); pk[2] = cvt_pk_bf16(r[4], r[5]); pk[3] = cvt_pk_bf16(r[6], r[7]);
                *(u32x4*)(op + db * 32 + 16 * k) = pk;
            }
    }
}

template <int LAYER>
__device__ __forceinline__ void decode_item(const Params& p, int idx, int wid, AttnItem& it) {
    bf16_t* U = (bf16_t*)(p.ws + WS_U); bf16_t* OG = (bf16_t*)(p.ws + WS_ACT);
    it.outk = nullptr; it.outv = nullptr; it.own_lo = 0; it.own_hi = 0;
    it.bias = nullptr; it.ck = nullptr; it.cv = nullptr; it.cstride = 0; it.sink2 = 0.f; it.kbase = 0; it.L = 0;
    if (LAYER == 0) {
        it.ustride = N1;
        if (idx >= 1024 && idx < 1088) {
            const int b = (idx - 1024) >> 3, h = idx & 7;
            it.kind = 1; it.L = 2048; it.nkeys = 2080; it.t_lo = 0; it.t_hi = 33;
            it.ck = p.in[4] + (size_t)b * 2048 * 512 + h * 64; it.cv = p.in[5] + (size_t)b * 2048 * 512 + h * 64; it.cstride = 512;
            const size_t r0 = (size_t)(MP + b * 32) * N1;
            it.uk = U + r0 + 2560 + h * 64; it.uv = U + r0 + 3072 + h * 64;
            it.active = (wid == 0); it.qpos0 = 2048;
            it.q = U + r0 + 2048 + h * 64; it.g = U + r0 + 3584 + h * 64; it.o = OG + (size_t)(MP + b * 32) * DM + 512 + h * 64;
        } else if (idx < 1024) {
            const int j = idx, qb = 7 - (j >> 7), r = j & 127, b = r >> 3, h = r & 7;
            it.kind = 1; it.nkeys = 2048; it.t_lo = 0; it.t_hi = 4 * qb + 4;
            it.own_lo = 4 * qb; it.own_hi = 4 * qb + 4;
            it.outk = p.out + O_BKP + (size_t)(b * 2048) * 512 + h * 64; it.outv = p.out + O_BVP + (size_t)(b * 2048) * 512 + h * 64;
            const size_t r0 = (size_t)(b * 2048) * N1;
            it.uk = U + r0 + 2560 + h * 64; it.uv = U + r0 + 3072 + h * 64;
            it.active = 1; it.qpos0 = qb * 256 + wid * 32;
            const size_t rq = (size_t)(b * 2048 + it.qpos0);
            it.q = U + rq * N1 + 2048 + h * 64; it.g = U + rq * N1 + 3584 + h * 64; it.o = OG + rq * DM + 512 + h * 64;
        } else if (idx >= 1152) {
            const int j = idx - 1152, cq = 7 - (j >> 7), r = j & 127, b = r >> 3, h = r & 7, c0 = 4 * cq;
            it.kind = 0; it.nkeys = 2048; it.t_lo = c0 - 8 < 0 ? 0 : c0 - 8; it.t_hi = c0 + 4;
            if (cq >= 6) {
                it.own_lo = c0; it.own_hi = c0 + 4;
                it.outk = p.out + O_AKP + ((size_t)(b * 512) * 512 + h * 64) - (size_t)1536 * 512; it.outv = p.out + O_AVP + ((size_t)(b * 512) * 512 + h * 64) - (size_t)1536 * 512;
            }
            const size_t r0 = (size_t)(b * 2048) * N1;
            it.uk = U + r0 + 512 + h * 64; it.uv = U + r0 + 1024 + h * 64;
            it.active = 1; it.qpos0 = c0 * 64 + wid * 32;
            const size_t rq = (size_t)(b * 2048 + it.qpos0);
            it.q = U + rq * N1 + h * 64; it.g = U + rq * N1 + 1536 + h * 64; it.o = OG + rq * DM + h * 64;
            it.bias = p.in[12] + h * 257;
        } else {
            const int j = idx - 1088, b = j >> 3, h = j & 7;
            it.kind = 0; it.L = 512; it.nkeys = 544; it.kbase = 1536; it.t_lo = 0; it.t_hi = 9;
            it.ck = p.in[2] + (size_t)b * 512 * 512 + h * 64; it.cv = p.in[3] + (size_t)b * 512 * 512 + h * 64; it.cstride = 512;
            const size_t r0 = (size_t)(MP + b * 32) * N1;
            it.uk = U + r0 + 512 + h * 64; it.uv = U + r0 + 1024 + h * 64;
            it.active = (wid == 0); it.qpos0 = 2048;
            it.q = U + r0 + h * 64; it.g = U + r0 + 1536 + h * 64; it.o = OG + (size_t)(MP + b * 32) * DM + h * 64;
            it.bias = p.in[12] + h * 257;
        }
    } else {
        it.ustride = N3; it.kind = 2;
        if (idx >= 1024 && idx < 1056) {
            const int b = (idx - 1024) >> 2, kvh = idx & 3, hq = kvh * 4 + (wid & 3);
            it.L = 128; it.nkeys = 160; it.kbase = 1920; it.t_lo = 0; it.t_hi = 3;
            it.ck = p.in[6] + (size_t)b * 128 * 256 + kvh * 64; it.cv = p.in[7] + (size_t)b * 128 * 256 + kvh * 64; it.cstride = 256;
            const size_t r0 = (size_t)(MP + b * 32) * N3;
            it.uk = U + r0 + 1024 + kvh * 64; it.uv = U + r0 + 1280 + kvh * 64;
            it.active = (wid < 4); it.qpos0 = 2048; it.sink2 = p.in[15][hq] * LOG2E;
            it.q = U + r0 + hq * 64; it.g = U + r0 + 1536 + hq * 64; it.o = OG + (size_t)(MP + b * 32) * DM + hq * 64;
        } else {
            const int j = idx < 1024 ? idx : idx - 32, c = 31 - (j >> 6), r = j & 63, b = r >> 2, kvh = r & 3, hq = kvh * 4 + (wid >> 1);
            it.nkeys = 2048; it.t_lo = c - 2 < 0 ? 0 : c - 2; it.t_hi = c + 1;
            const size_t r0 = (size_t)(b * 2048) * N3;
            it.uk = U + r0 + 1024 + kvh * 64; it.uv = U + r0 + 1280 + kvh * 64;
            it.active = 1; it.qpos0 = c * 64 + (wid & 1) * 32; it.sink2 = p.in[15][hq] * LOG2E;
            const size_t rq = (size_t)(b * 2048 + it.qpos0);
            it.q = U + rq * N3 + hq * 64; it.g = U + rq * N3 + 1536 + hq * 64; it.o = OG + rq * DM + hq * 64;
        }
    }
}

__device__ __forceinline__ void attn_c_pair(const Params& p, int idx, int wid, LAS unsigned char* lds, int tid, int lane, unsigned* qctr, int& pre) {
    const bf16_t* U = (const bf16_t*)(p.ws + WS_U); bf16_t* OG = (bf16_t*)(p.ws + WS_ACT);
    const int cp = 15 - (idx >> 6), r = idx & 63, b = r >> 2, kvh = r & 3, c0 = 2 * cp;
    const int t_lo = c0 - 2 < 0 ? 0 : c0 - 2, t_hi = c0 + 2;
    const int lkey = tid >> 3, lc = tid & 7;
    u32x4 kr[4], vr[4];
#pragma unroll
    for (int i = 0; i < 4; ++i) {
        const int t = t_lo + i;
        if (t < t_hi) {
            const bf16_t* rp = U + (size_t)(b * 2048 + 64 * t + lkey) * N3 + kvh * 64 + 8 * lc;
            kr[i] = *(const u32x4*)(rp + 1024); vr[i] = *(const u32x4*)(rp + 1280);
        }
    }
    if (tid == 0) pre = (int)atomicAdd(qctr, 1u);
#pragma unroll
    for (int i = 0; i < 4; ++i) {
        const int t = t_lo + i;
        if (t < t_hi) {
            const int sl = t & 3;
            *(LAS u32x4*)(lds + L_K + sl * (64 * KST) + lkey * KST + lc * 16) = kr[i];
            *(LAS u32x4*)(lds + L_V + sl * (64 * VST) + lkey * VST + lc * 16) = vr[i];
        }
    }
    asm volatile("s_waitcnt lgkmcnt(0)" ::: "memory"); __builtin_amdgcn_s_barrier(); asm volatile("" ::: "memory");
    const int hq = kvh * 4 + (wid >> 1);
    const float sink2 = p.in[15][hq] * LOG2E;
#pragma unroll 1
    for (int g = 0; g < 2; ++g) {
        const int c = c0 + g;
        AttnItem it;
        it.kind = 2; it.t_lo = c - 2 < 0 ? 0 : c - 2; it.t_hi = c + 1; it.kbase = 0; it.nkeys = 2048; it.L = 0;
        it.ck = nullptr; it.cv = nullptr; it.cstride = 0; it.uk = nullptr; it.uv = nullptr; it.ustride = N3; it.bias = nullptr;
        it.outk = nullptr; it.outv = nullptr; it.own_lo = 0; it.own_hi = 0;
        it.active = 1; it.qpos0 = c * 64 + (wid & 1) * 32; it.sink2 = sink2;
        const size_t rq = (size_t)(b * 2048 + it.qpos0);
        it.q = U + rq * N3 + hq * 64; it.g = U + rq * N3 + 1536 + hq * 64; it.o = OG + rq * DM + hq * 64;
        int dummy = 0;
        attn_run<2, true>(it, lds, tid, lane, qctr, dummy);
    }
}

template <int LAYER>
__device__ __forceinline__ void phase_attn(const Params& p, LAS unsigned char* lds, int rep) {
    const int tid = opaque_tid(), wid = __builtin_amdgcn_readfirstlane(tid >> 6), lane = tid & 63;
    constexpr int nitems = LAYER == 0 ? 2176 : 1056;
    unsigned* ctr = (unsigned*)(p.ws + WS_CTL) + LAYER * 16 + rep;
    LAS int* itl = (LAS int*)(lds + L_IT);
    __syncthreads();
    if (tid == 0) itl[0] = (int)atomicAdd(ctr, 1u);
    __syncthreads();
    int idx = itl[0], slot = 0;
    bool samp_ok = false;
    while (idx < nitems) {
        int pre = 0;
        if (idx >= 1024 && idx < (LAYER == 0 ? 1152 : 1056) && !samp_ok) { block_wait((unsigned*)(p.ws + WS_CTL) + CW_SAMP(LAYER == 0 ? 1 : 5), LAYER == 0 ? N1 / 256 : N3 / 256); samp_ok = true; }
        if (LAYER == 1 && idx < 1024) attn_c_pair(p, idx, wid, lds, tid, lane, ctr, pre);
        else {
            AttnItem it;
            decode_item<LAYER>(p, idx, wid, it);
            if (LAYER == 0) { if (it.kind == 0) attn_run<0>(it, lds, tid, lane, ctr, pre); else attn_run<1>(it, lds, tid, lane, ctr, pre); }
            else attn_run<2>(it, lds, tid, lane, ctr, pre);
        }
        if (tid == 0) itl[slot ^ 1] = pre;
        asm volatile("s_waitcnt lgkmcnt(0)" ::: "memory"); __builtin_amdgcn_s_barrier(); asm volatile("" ::: "memory");
        slot ^= 1; idx = itl[slot];
    }
}

struct SplitOrder {
    pg8::StaticOrder so; int mode, c, nN;
    __device__ __forceinline__ void init(int N, int G, int c_, int mode_) { so.init(MP, N, G, c_); mode = mode_; c = c_; nN = N / 256; }
    __device__ __forceinline__ bool next(int i, pg8::Unit& u) const {
        if (mode == 0) return so.next(i, u);
        if (i > 0 || c >= nN) return false;
        u.pm = 128; u.pn = c; return true;
    }
    __device__ __forceinline__ void a_ready(const pg8::Unit&) const {}
    __device__ __forceinline__ void done(const pg8::Unit&) const {}
};

#define XB_TMO      128
#define XB_XCNT(j)  (256  + 64 * (j))
#define XB_XSUB(j)  (1280 + 64 * (j))
#define XB_XGEN(j)  (2304 + 64 * (j))
#define XB_TOP      3328
#define XB_TOPGEN   3392
#define XCD_BAR_WORDS 3456
#define XB_SPIN_CAP (1u << 18)

__device__ __forceinline__ unsigned xb_ld(unsigned* p)              { return __hip_atomic_load(p, __ATOMIC_RELAXED, __HIP_MEMORY_SCOPE_AGENT); }
__device__ __forceinline__ unsigned xb_add(unsigned* p, unsigned v) { return __hip_atomic_fetch_add(p, v, __ATOMIC_RELAXED, __HIP_MEMORY_SCOPE_AGENT); }
__device__ __forceinline__ unsigned xb_xcc_id() { return (unsigned)__builtin_amdgcn_s_getreg((3 << 11) | 20) & 0xFu; }
#define XB_SPIN(cond, bar) do { unsigned _sp = 0; while (cond) { __builtin_amdgcn_s_sleep(1); \
    if ((++_sp & 255u) == 0u) { if (xb_ld(&(bar)[XB_TMO])) break; if (_sp > XB_SPIN_CAP) { atomicAdd(&(bar)[XB_TMO], 1u); break; } } } } while (0)

struct XcdBarrier {
    unsigned* bar; unsigned x;
    volatile LAS unsigned* st;
};

__device__ __forceinline__ XcdBarrier xcd_barrier_post(unsigned* bar, volatile LAS unsigned* st) {
    XcdBarrier b; b.bar = bar; b.x = xb_xcc_id(); b.st = st;
    if (threadIdx.x == 0) (void)xb_add(&bar[XB_XCNT(b.x)], 1u);
    return b;
}
__device__ __forceinline__ void xcd_barrier_complete(unsigned* bar, unsigned x, unsigned& nloc, unsigned& nx) {
    const unsigned G = gridDim.x * gridDim.y * gridDim.z;
    unsigned sum, cnt, mine, sp = 0u;
    for (;;) {
        sum = 0u; cnt = 0u; mine = 0u;
#pragma unroll
        for (unsigned j = 0; j < 16; ++j) { const unsigned c = xb_ld(&bar[XB_XCNT(j)]); sum += c; cnt += (c > 0u) ? 1u : 0u; mine = (j == x) ? c : mine; }
        if (sum == G) break;
        __builtin_amdgcn_s_sleep(1);
        if ((++sp & 255u) == 0u) { if (xb_ld(&bar[XB_TMO])) break; if (sp > XB_SPIN_CAP) { atomicAdd(&bar[XB_TMO], 1u); break; } }
    }
    nloc = mine > 0u ? mine : 1u; nx = cnt > 0u ? cnt : 1u;
}

__device__ __forceinline__ void xcd_barrier(const XcdBarrier& b) {
    asm volatile("s_waitcnt vmcnt(0)" ::: "memory");
    __syncthreads();
    if (threadIdx.x < 64 && b.st[0] == 0u) {
        const unsigned ln = threadIdx.x, G = gridDim.x * gridDim.y * gridDim.z;
        unsigned c = 0u, sum = 0u, sp = 0u;
        for (;;) {
            c = ln < 16u ? xb_ld(&b.bar[XB_XCNT(ln)]) : 0u;
            sum = c;
#pragma unroll
            for (int o = 8; o; o >>= 1) sum += (unsigned)__shfl_xor((int)sum, o);
            sum = (unsigned)__shfl((int)sum, 0);
            if (sum == G) break;
            __builtin_amdgcn_s_sleep(1);
            if ((++sp & 255u) == 0u) { if (xb_ld(&b.bar[XB_TMO])) break; if (sp > XB_SPIN_CAP) { if (ln == 0u) atomicAdd(&b.bar[XB_TMO], 1u); break; } }
        }
        const unsigned long long pop = __ballot(c > 0u);
        const unsigned mine = (unsigned)__shfl((int)c, (int)b.x);
        if (ln == 0u) { b.st[0] = mine > 0u ? mine : 1u; b.st[1] = pop ? (unsigned)__popcll(pop) : 1u; }
    }
    if (threadIdx.x == 0) {
        unsigned* bar = b.bar;
        __builtin_amdgcn_s_waitcnt(0);
        unsigned nloc = b.st[0], nx = b.st[1];
        if (nloc == 0u) { xcd_barrier_complete(bar, b.x, nloc, nx); b.st[0] = nloc; b.st[1] = nx; }
        const unsigned old = xb_add(&bar[XB_XSUB(b.x)], 1u);
        const unsigned gen = old / nloc;
        if (old + 1u == (gen + 1u) * nloc) {
            __builtin_amdgcn_fence(__ATOMIC_RELEASE, "agent");
            asm volatile("s_waitcnt vmcnt(0)" ::: "memory");
            const unsigned og = xb_add(&bar[XB_TOP], 1u);
            const unsigned tg = og / nx;
            if (og + 1u == (tg + 1u) * nx) xb_add(&bar[XB_TOPGEN], 1u);
            else XB_SPIN(xb_ld(&bar[XB_TOPGEN]) == tg, bar);
            __builtin_amdgcn_fence(__ATOMIC_ACQUIRE, "agent");
            xb_add(&bar[XB_XGEN(b.x)], 1u);
            asm volatile("s_waitcnt vmcnt(0)" ::: "memory");
        } else {
            XB_SPIN(xb_ld(&bar[XB_XGEN(b.x)]) == gen, bar);
            __builtin_amdgcn_fence(__ATOMIC_ACQUIRE, "agent");
            asm volatile("s_waitcnt vmcnt(0)" ::: "memory");
        }
    }
    __syncthreads();
}

__device__ __forceinline__ void soft_grid_bar(unsigned* word, unsigned nblocks) {
    asm volatile("s_waitcnt vmcnt(0)" ::: "memory");
    __syncthreads();
    if (threadIdx.x == 0) {
        __builtin_amdgcn_fence(__ATOMIC_RELEASE, "agent");
        asm volatile("s_waitcnt vmcnt(0)" ::: "memory");
        __hip_atomic_fetch_add(word, 1u, __ATOMIC_RELAXED, __HIP_MEMORY_SCOPE_AGENT);
        unsigned spins = 0;
        while (__hip_atomic_load(word, __ATOMIC_RELAXED, __HIP_MEMORY_SCOPE_AGENT) < nblocks && ++spins < (1u << 21)) __builtin_amdgcn_s_sleep(1);
        __builtin_amdgcn_fence(__ATOMIC_ACQUIRE, "agent");
        asm volatile("s_waitcnt vmcnt(0)" ::: "memory");
    }
    __syncthreads();
}

__global__ void __launch_bounds__(512, 2) mk_fwd(Params p) {
    extern __shared__ __attribute__((aligned(16))) unsigned char shm[];
    LAS unsigned char* lds = (LAS unsigned char*)shm;
    cg::grid_group grid = cg::this_grid();
#ifndef REPM
#define REPM 0
#endif
    unsigned* cw = (unsigned*)(p.ws + WS_CTL);
    volatile LAS unsigned* xst = (volatile LAS unsigned*)(lds + 131072);
    if (threadIdx.x == 0) { xst[0] = 0u; xst[1] = 0u; }
    __syncthreads();
    XcdBarrier xb; xb.bar = (unsigned*)(p.ws + WS_XB); xb.x = 0; xb.st = xst;
    for (int ph = p.ph_lo; ph < p.ph_hi; ++ph) {
        if (ph == 1) { grid.sync(); xb = xcd_barrier_post((unsigned*)(p.ws + WS_XB), xst); }
        else if (ph == 3 || ph == 5 || ph == 7) xcd_barrier(xb);
        if (ph == 0) phase_prep(p, lds);
        else if (ph == 1) {
            for (int part = 0; part < 2; ++part) {
                const int bid = opaque_bid();
                if (part == 1) { xcd_barrier(xb); if (bid >= N1 / 256) break; }
                pg8::Gemm g; g.A = (const bf16_t*)(p.ws + WS_ACT); g.Bt = (const bf16_t*)(p.ws + WS_W1T); g.M = MT; g.N = N1; g.K = DM;
                SplitOrder S; S.init(N1, (int)gridDim.x, bid, part);
                Epi1 E; E.U = (bf16_t*)(p.ws + WS_U); E.out = p.out;
                pg8::gemm_phase<Epi1, SplitOrder>(lds, g, S, E);
                if (part == 1) block_signal(cw + CW_SAMP(ph));
            }
        } else if (ph == 2) phase_attn<0>(p, lds, 0);
        else if (ph == 3 || ph == 7) {
            for (int part = 0; part < 2; ++part) {
                const int bid = opaque_bid();
                if (part == 1) { xcd_barrier(xb); if (bid >= DM / 256) break; }
                pg8::Gemm g; g.A = (const bf16_t*)(p.ws + WS_ACT); g.Bt = (const bf16_t*)(p.ws + (ph == 3 ? WS_W2T : WS_W4T)); g.M = MT; g.N = DM; g.K = DM;
                SplitOrder S; S.init(DM, (int)gridDim.x, bid, part);
                Epi2 E; E.Y = (bf16_t*)(p.ws + WS_Y); E.ssq = (float*)(p.ws + WS_SSQ);
                pg8::gemm_phase<Epi2, SplitOrder>(lds, g, S, E);
                if (part == 1) block_signal(cw + CW_SAMP(ph));
            }
        } else if (ph == 4) phase_mid(p);
        else if (ph == 5) {
            for (int part = 0; part < 2; ++part) {
                const int bid = opaque_bid();
                if (part == 1) { xcd_barrier(xb); if (bid >= N3 / 256) break; }
                pg8::Gemm g; g.A = (const bf16_t*)(p.ws + WS_ACT); g.Bt = (const bf16_t*)(p.ws + WS_W3T); g.M = MT; g.N = N3; g.K = DM;
                SplitOrder S; S.init(N3, (int)gridDim.x, bid, part);
                Epi3 E; E.U = (bf16_t*)(p.ws + WS_U); E.out = p.out; E.ropc = (const float*)(p.ws + WS_ROPC); E.rops = (const float*)(p.ws + WS_ROPS);
                pg8::gemm_phase<Epi3, SplitOrder>(lds, g, S, E);
                if (part == 1) block_signal(cw + CW_SAMP(ph));
            }
        } else if (ph == 6) phase_attn<1>(p, lds, 0);
        else phase_fin(p);
    }
}

constexpr int LDS_BYTES = 131072 + 16;
constexpr int N_PHASES = 9;
#ifndef MK_LAUNCHES
#define MK_LAUNCHES 1
#endif

extern "C" void kernel_launch(void* const* d_in, const int* in_sizes, int n_in, void* d_out, int out_size, void* d_ws, size_t ws_size, hipStream_t stream) {
    static int grid = 0;
    if (grid == 0) {
        if (n_in != 18 || (size_t)out_size != O_END || ws_size < WS_END) { fprintf(stderr, "kernel_launch: unexpected shapes (n_in %d out %d ws %zu)\n", n_in, out_size, ws_size); grid = -1; return; }
        int dev = 0, cus = 0, per_cu = 0;
        hipGetDevice(&dev);
        hipDeviceGetAttribute(&cus, hipDeviceAttributeMultiprocessorCount, dev);
        hipFuncSetAttribute((const void*)mk_fwd, hipFuncAttributeMaxDynamicSharedMemorySize, LDS_BYTES);
        hipOccupancyMaxActiveBlocksPerMultiprocessor(&per_cu, (const void*)mk_fwd, 512, LDS_BYTES);
        if (per_cu < 1) { fprintf(stderr, "kernel_launch: occupancy query says %d blocks per CU\n", per_cu); per_cu = 1; }
        grid = cus * per_cu;
        fprintf(stderr, "kernel_launch: grid %d (%d CUs x %d)\n", grid, cus, per_cu);
    }
    if (grid < 0) return;
    Params p{};
    for (int i = 0; i < 18; ++i) p.in[i] = (const float*)d_in[i];
    p.out = (float*)d_out; p.ws = (unsigned char*)d_ws;
#if MK_LAUNCHES == 1
    p.ph_lo = 0; p.ph_hi = N_PHASES;
    void* args[] = {&p};
    hipError_t e = hipLaunchCooperativeKernel((const void*)mk_fwd, dim3(grid), dim3(512), args, LDS_BYTES, stream);
    if (e != hipSuccess) fprintf(stderr, "cooperative launch failed: %s (grid %d)\n", hipGetErrorString(e), grid);
#else
    for (int ph = 0; ph < N_PHASES; ++ph) {
        p.ph_lo = ph; p.ph_hi = ph + 1;
        hipLaunchKernelGGL(mk_fwd, dim3(grid), dim3(512), LDS_BYTES, stream, p);
    }
#endif
}
```

```cpp
#include <hip/hip_runtime.h>
#include <hip/hip_cooperative_groups.h>
#include <cstdio>
namespace cg = cooperative_groups;
namespace pg8 {
#define PG8_LAS __attribute__((address_space(3)))
typedef unsigned short bf16_t;
typedef short bf16x8 __attribute__((ext_vector_type(8)));
typedef float f32x4 __attribute__((ext_vector_type(4)));
typedef unsigned u32x4 __attribute__((ext_vector_type(4)));
constexpr int BM = 256, BK = 64, HALF = 128, HTB = HALF * BK * 2  , STAGE_BYTES = 8 * HTB, NXCD = 8, WGM = 8;

__host__ __device__ __forceinline__ int lds_byte(int r, int c) { const int st = (r >> 4) * 2 + (c >> 5), rr = r & 15, cc = c & 31, ob = rr * 64 + cc * 2; return st * 1024 + (ob ^ (((ob >> 9) & 1) << 5)); }
__host__ __device__ __forceinline__ void stage_rc(int b, int& R, int& C) { const int st = b / 1024, sb = b % 1024, swz = sb ^ (((sb >> 9) & 1) << 5); R = (st >> 1) * 16 + swz / 64; C = (st & 1) * 32 + (swz % 64) / 2; }
__host__ __device__ __forceinline__ int perm32(int rho) { const int n = rho >> 4, i = rho & 15; return 8 * (i >> 2) + 4 * n + (i & 3); }

struct Unit { int pm, pn; };
struct Gemm { const bf16_t* A; const bf16_t* Bt; int M, N, K; };

struct StaticOrder {
    int nM, nN, nwg, G, c;
    __host__ __device__ void init(int M, int N, int G_, int c_) { nM = M / BM; nN = N / BM; nwg = nM * nN; G = G_; c = c_; }
    __host__ __device__ bool next(int i, Unit& u) const {
        const long L = (long)i * G + c; if (L >= nwg) return false;
        int wgid = (int)L; { const int q = nwg / NXCD, r = nwg % NXCD, xcd = wgid % NXCD, off = wgid / NXCD; wgid = (xcd < r ? xcd * (q + 1) : r * (q + 1) + (xcd - r) * q) + off; }
        const int nig = WGM * nN, gid = wgid / nig, fm = gid * WGM, gsz = (nM - fm) < WGM ? (nM - fm) : WGM;
        u.pm = fm + ((wgid % nig) % gsz); u.pn = (wgid % nig) / gsz; return true;
    }
    __device__ __forceinline__ void a_ready(const Unit&) const {}
    __device__ __forceinline__ void done(const Unit&) const {}
};
__device__ __forceinline__ unsigned cvt_pk_bf16(float lo, float hi) { unsigned r; asm volatile("v_cvt_pk_bf16_f32 %0, %1, %2" : "=v"(r) : "v"(lo), "v"(hi)); return r; }
template <class Epi, class Sched>
__device__ __forceinline__ void gemm_phase(PG8_LAS unsigned char* lds, const Gemm g, const Sched& S, const Epi& E) {
    int tid = threadIdx.x; asm volatile("" : "+v"(tid));
    const int wid = __builtin_amdgcn_readfirstlane(tid >> 6), lane = tid & 63, wr = wid >> 2, wc = wid & 3, fr = lane & 15, fq = lane >> 4;
    const int K = g.K, nt = K / BK;
    unsigned voffA[2], voffB[2];
#pragma unroll
    for (int i = 0; i < 2; ++i) { int R, C; stage_rc(tid * 16 + i * 8192, R, C); const int Rb = Epi::PERM ? ((R & ~31) + perm32(R & 31)) : R;
        voffA[i] = (unsigned)(R * K + C) * 2u; voffB[i] = (unsigned)(Rb * K + C) * 2u; }
    const size_t kstep = (size_t)(BK * 2);
    const size_t hstep = (size_t)HALF * K * 2;
    const size_t tstep = 2 * hstep;
    const unsigned ldsw = (unsigned)wid * 1024u;
    const int aoff = lds_byte(wr * 64 + fr, fq * 8), boff = lds_byte(wc * 32 + fr, fq * 8);
#define PG8_SA(b, h) (((b) * 2 + (h)) * HTB)
#define PG8_SB(b, h) ((4 + (b) * 2 + (h)) * HTB)
#define PG8_STAGE(bufoff, gbase, voff) do { _Pragma("unroll") for (int _i = 0; _i < 2; ++_i) \
        __builtin_amdgcn_global_load_lds((const unsigned*)((const char*)(gbase) + (voff)[_i]), (PG8_LAS unsigned*)(lds + (bufoff) + ldsw + _i * 8192), 16, 0, 0); } while (0)
#define PG8_LDA(dst, b, h) do { _Pragma("unroll") for (int m = 0; m < 4; ++m) _Pragma("unroll") for (int k = 0; k < 2; ++k) dst[m][k] = *(const PG8_LAS bf16x8*)(lds + PG8_SA(b, h) + aoff + m * 2048 + k * 1024); } while (0)
#define PG8_LDB(dst, b, h) do { _Pragma("unroll") for (int n = 0; n < 2; ++n) _Pragma("unroll") for (int k = 0; k < 2; ++k) dst[n][k] = *(const PG8_LAS bf16x8*)(lds + PG8_SB(b, h) + boff + n * 2048 + k * 1024); } while (0)
#define PG8_MMA(ai, bj, At, Bt) do { __builtin_amdgcn_s_setprio(1); _Pragma("unroll") for (int m = 0; m < 4; ++m) _Pragma("unroll") for (int n = 0; n < 2; ++n) _Pragma("unroll") for (int k = 0; k < 2; ++k) \
        acc[ai][bj][m][n] = __builtin_amdgcn_mfma_f32_16x16x32_bf16(Bt[n][k], At[m][k], acc[ai][bj][m][n], 0, 0, 0); __builtin_amdgcn_s_setprio(0); } while (0)
#define PG8_WAIT_V(n) asm volatile("s_waitcnt vmcnt(" #n ")" ::: "memory")
#define PG8_WAIT_L(n) asm volatile("s_waitcnt lgkmcnt(" #n ")" ::: "memory")
#define PG8_BAR __builtin_amdgcn_s_barrier()
#define PG8_SCHED __builtin_amdgcn_sched_barrier(0)
    Unit cur, nxt; int ui = 0;
    if (!S.next(0, cur)) return;
    f32x4 acc[2][2][4][2];
#pragma unroll
    for (int a = 0; a < 2; ++a)
#pragma unroll
        for (int b = 0; b < 2; ++b)
#pragma unroll
            for (int m = 0; m < 4; ++m)
#pragma unroll
                for (int n = 0; n < 2; ++n) acc[a][b][m][n] = (f32x4){0.f, 0.f, 0.f, 0.f};
    bf16x8 At[4][2], B0[2][2], B1[2][2];
    const char* cA = (const char*)g.A + (size_t)cur.pm * tstep; const char* cB = (const char*)g.Bt + (size_t)cur.pn * tstep;
    S.a_ready(cur);
    PG8_STAGE(PG8_SB(0, 0), cB, voffB); PG8_STAGE(PG8_SA(0, 0), cA, voffA); PG8_STAGE(PG8_SB(0, 1), cB + hstep, voffB); PG8_STAGE(PG8_SA(0, 1), cA + hstep, voffA);
    if (wr == 1) PG8_BAR;
    PG8_WAIT_V(4); PG8_BAR;
    PG8_STAGE(PG8_SB(1, 0), cB + kstep, voffB); PG8_STAGE(PG8_SA(1, 0), cA + kstep, voffA); PG8_STAGE(PG8_SB(1, 1), cB + hstep + kstep, voffB);
    PG8_WAIT_V(6); PG8_BAR;
    for (;;) {
        const bool has_next = S.next(ui + 1, nxt);
        const char* nA = has_next ? (const char*)g.A + (size_t)nxt.pm * tstep : cA; const char* nB = has_next ? (const char*)g.Bt + (size_t)nxt.pn * tstep : cB;
        for (int t = 0; t < nt; t += 2) {
            const bool last = (t == nt - 2);
            const char* a1 = cA + (size_t)(t + 1) * kstep;
            const char* a2 = last ? nA : cA + (size_t)(t + 2) * kstep; const char* b2 = last ? nB : cB + (size_t)(t + 2) * kstep;
            const char* a3 = a2 + kstep; const char* b3 = b2 + kstep;
            if (last && has_next) S.a_ready(nxt);
            PG8_LDB(B0, 0, 0); PG8_SCHED; PG8_LDA(At, 0, 0); PG8_STAGE(PG8_SA(1, 1), a1 + hstep, voffA);
            PG8_WAIT_L(8); PG8_BAR; PG8_WAIT_L(0); PG8_MMA(0, 0, At, B0); PG8_BAR; PG8_SCHED;
            PG8_LDB(B1, 0, 1); PG8_STAGE(PG8_SB(0, 0), b2, voffB);
            PG8_BAR; PG8_WAIT_L(0); PG8_MMA(0, 1, At, B1); PG8_BAR;
            PG8_LDA(At, 0, 1); PG8_STAGE(PG8_SA(0, 0), a2, voffA);
            PG8_BAR; PG8_WAIT_L(0); PG8_MMA(1, 0, At, B0); PG8_BAR; PG8_SCHED;
            PG8_STAGE(PG8_SB(0, 1), b2 + hstep, voffB);
            PG8_WAIT_V(6); PG8_BAR; PG8_MMA(1, 1, At, B1); PG8_BAR;
            PG8_LDB(B0, 1, 0); PG8_SCHED; PG8_LDA(At, 1, 0); PG8_STAGE(PG8_SA(0, 1), a2 + hstep, voffA);
            PG8_WAIT_L(8); PG8_BAR; PG8_WAIT_L(0); PG8_MMA(0, 0, At, B0); PG8_BAR; PG8_SCHED;
            PG8_LDB(B1, 1, 1); PG8_STAGE(PG8_SB(1, 0), b3, voffB);
            PG8_BAR; PG8_WAIT_L(0); PG8_MMA(0, 1, At, B1); PG8_BAR;
            PG8_LDA(At, 1, 1); PG8_STAGE(PG8_SA(1, 0), a3, voffA);
            PG8_BAR; PG8_WAIT_L(0); PG8_MMA(1, 0, At, B0); PG8_BAR; PG8_SCHED;
            PG8_STAGE(PG8_SB(1, 1), b3 + hstep, voffB);
            PG8_WAIT_V(6); PG8_BAR; PG8_MMA(1, 1, At, B1); PG8_BAR;
        }
        if constexpr (!Epi::AFTER_DRAIN) { E(acc, cur, wr, wc, fr, fq); S.done(cur); }
        if (!has_next) break;
#pragma unroll
        for (int a = 0; a < 2; ++a)
#pragma unroll
            for (int b = 0; b < 2; ++b)
#pragma unroll
                for (int m = 0; m < 4; ++m)
#pragma unroll
                    for (int n = 0; n < 2; ++n) acc[a][b][m][n] = (f32x4){0.f, 0.f, 0.f, 0.f};
        cur = nxt; cA = nA; cB = nB; ++ui;
    }
    PG8_WAIT_V(0);
    if (wr == 0) PG8_BAR;
    PG8_BAR;
    if constexpr (Epi::AFTER_DRAIN) { E.fused(acc, cur, wr, wc, fr, fq, lds, wid, lane); S.done(cur); }
#undef PG8_SA
#undef PG8_SB
#undef PG8_STAGE
#undef PG8_LDA
#undef PG8_LDB
#undef PG8_MMA
#undef PG8_WAIT_V
#undef PG8_WAIT_L
#undef PG8_BAR
#undef PG8_SCHED
}
}

using pg8::bf16_t; using pg8::bf16x8; using pg8::f32x4; using pg8::u32x4; using pg8::cvt_pk_bf16;
#define LAS PG8_LAS
typedef float f32x16 __attribute__((ext_vector_type(16)));
typedef unsigned u32x2 __attribute__((ext_vector_type(2)));

constexpr int MP = 32768, MS = 256, MT = MP + MS, DM = 1024, N1 = 4096, N3 = 2560;
constexpr float LOG2E = 1.4426950408889634f;
constexpr size_t WS_ACT = 0;
constexpr size_t WS_Y   = WS_ACT + (size_t)MT * DM * 2;
constexpr size_t WS_U   = WS_Y + (size_t)MT * DM * 2;
constexpr size_t WS_W1T = WS_U + (size_t)MT * N1 * 2;
constexpr size_t WS_W2T = WS_W1T + (size_t)N1 * DM * 2;
constexpr size_t WS_W3T = WS_W2T + (size_t)DM * DM * 2;
constexpr size_t WS_W4T = WS_W3T + (size_t)N3 * DM * 2;
constexpr size_t WS_ROPC = WS_W4T + (size_t)DM * DM * 2;
constexpr size_t WS_ROPS = WS_ROPC + 2112 * 32 * 4;
constexpr size_t WS_SSQ = WS_ROPS + 2112 * 32 * 4;
constexpr size_t WS_CTL = WS_SSQ + (size_t)MT * 16 * 4;
constexpr size_t WS_XB = WS_CTL + 4096;
constexpr size_t WS_Y1 = WS_XB + 16384;
constexpr size_t WS_END = WS_Y1 + (size_t)MT * DM * 2;
constexpr size_t O_YP = 0;
constexpr size_t O_YS = O_YP + (size_t)MP * DM;
constexpr size_t O_AKP = O_YS + (size_t)MS * DM;
constexpr size_t O_AVP = O_AKP + (size_t)16 * 512 * 512;
constexpr size_t O_BKP = O_AVP + (size_t)16 * 512 * 512;
constexpr size_t O_BVP = O_BKP + (size_t)MP * 512;
constexpr size_t O_CKP = O_BVP + (size_t)MP * 512;
constexpr size_t O_CVP = O_CKP + (size_t)16 * 128 * 256;
constexpr size_t O_AKS = O_CVP + (size_t)16 * 128 * 256;
constexpr size_t O_AVS = O_AKS + (size_t)256 * 512;
constexpr size_t O_BKS = O_AVS + (size_t)256 * 512;
constexpr size_t O_BVS = O_BKS + (size_t)256 * 512;
constexpr size_t O_CKS = O_BVS + (size_t)256 * 512;
constexpr size_t O_CVS = O_CKS + (size_t)256 * 256;
constexpr size_t O_END = O_CVS + (size_t)256 * 256;

#define CW_QEL(k)  (448 + 16 * (k))
#define CW_BAR(k)  (64 + 16 * (k))
#define CW_SAMP(ph) (320 + 16 * (ph))
struct Params {
    const float* in[18];
    float* out;
    unsigned char* ws;
    int ph_lo, ph_hi;
};

__device__ __forceinline__ float bf_lo(unsigned w) { return __uint_as_float(w << 16); }
__device__ __forceinline__ float bf_hi(unsigned w) { return __uint_as_float(w & 0xffff0000u); }
__device__ __forceinline__ float wave_sum(float v) {
#pragma unroll
    for (int o = 32; o; o >>= 1) v += __shfl_xor(v, o);
    return v;
}
__device__ __forceinline__ int opaque_tid() { int t = threadIdx.x; asm volatile("" : "+v"(t)); return t; }
__device__ __forceinline__ int opaque_bid() { int b = blockIdx.x; asm volatile("" : "+s"(b)); return b; }
__device__ __forceinline__ void block_wait(unsigned* word, unsigned need) {
    if (threadIdx.x == 0) {
        unsigned spins = 0;
        while (__hip_atomic_load(word, __ATOMIC_RELAXED, __HIP_MEMORY_SCOPE_AGENT) < need && ++spins < (1u << 21)) __builtin_amdgcn_s_sleep(1);
        __builtin_amdgcn_fence(__ATOMIC_ACQUIRE, "agent");
        asm volatile("s_waitcnt vmcnt(0)" ::: "memory");
    }
    __syncthreads();
}
__device__ __forceinline__ void wave_wait(unsigned* word, unsigned need) {
    unsigned spins = 0;
    while (__hip_atomic_load(word, __ATOMIC_RELAXED, __HIP_MEMORY_SCOPE_AGENT) < need && ++spins < (1u << 21)) __builtin_amdgcn_s_sleep(1);
    __builtin_amdgcn_fence(__ATOMIC_ACQUIRE, "agent");
    asm volatile("s_waitcnt vmcnt(0)" ::: "memory");
}
__device__ __forceinline__ void block_signal(unsigned* word) {
    asm volatile("s_waitcnt vmcnt(0)" ::: "memory");
    __syncthreads();
    if (threadIdx.x == 0) {
        __builtin_amdgcn_fence(__ATOMIC_RELEASE, "agent");
        asm volatile("s_waitcnt vmcnt(0)" ::: "memory");
        __hip_atomic_fetch_add(word, 1u, __ATOMIC_RELAXED, __HIP_MEMORY_SCOPE_AGENT);
    }
}
__device__ __forceinline__ float fexp2(float x) { return __builtin_amdgcn_exp2f(x); }
__device__ __forceinline__ float flog2(float x) { return __builtin_amdgcn_logf(x); }

struct Epi1 {
    static constexpr bool PERM = true, AFTER_DRAIN = false;
    bf16_t* U; float* out;
    __device__ __forceinline__ void operator()(const f32x4 (&acc)[2][2][4][2], const pg8::Unit& u, int wr, int wc, int fr, int fq) const {
        const int reg = u.pn >> 1;
        const bool isA = (reg == 1 || reg == 2), isB = (reg == 5 || reg == 6);
        const int cin = (u.pn & 1) * 256 + wc * 32 + 8 * fq;
        const size_t so = reg == 1 ? O_AKS : reg == 2 ? O_AVS : reg == 5 ? O_BKS : O_BVS;
#pragma unroll
        for (int ai = 0; ai < 2; ++ai)
#pragma unroll
            for (int m = 0; m < 4; ++m) {
                const int row = u.pm * 256 + ai * 128 + wr * 64 + m * 16 + fr;
                bf16_t* up = U + (size_t)row * N1 + u.pn * 256 + wc * 32 + 8 * fq;
                float* fo = nullptr;
                if ((isA || isB) && row >= MP) fo = out + so + (size_t)(row - MP) * 512;
#pragma unroll
                for (int bj = 0; bj < 2; ++bj) {
                    const f32x4 v0 = acc[ai][bj][m][0], v1 = acc[ai][bj][m][1];
                    u32x4 pk; pk[0] = cvt_pk_bf16(v0[0], v0[1]); pk[1] = cvt_pk_bf16(v0[2], v0[3]); pk[2] = cvt_pk_bf16(v1[0], v1[1]); pk[3] = cvt_pk_bf16(v1[2], v1[3]);
                    *(u32x4*)(up + bj * 128) = pk;
                    if (fo) { *(f32x4*)(fo + cin + bj * 128) = v0; *(f32x4*)(fo + cin + bj * 128 + 4) = v1; }
                }
            }
    }
};
struct Epi3 {
    static constexpr bool PERM = true, AFTER_DRAIN = false;
    bf16_t* U; float* out; const float* ropc; const float* rops;
    __device__ __forceinline__ void operator()(const f32x4 (&acc)[2][2][4][2], const pg8::Unit& u, int wr, int wc, int fr, int fq) const {
        const int pn = u.pn;
        const bool rope = pn <= 4, kv = (pn == 4 || pn == 5);
        const int d8 = 8 * fq;
#pragma unroll
        for (int ai = 0; ai < 2; ++ai)
#pragma unroll
            for (int m = 0; m < 4; ++m) {
                const int row = u.pm * 256 + ai * 128 + wr * 64 + m * 16 + fr;
                bf16_t* ur = U + (size_t)row * N3;
                float* fo = nullptr;
                if (kv) {
                    if (row >= MP) fo = out + (pn == 4 ? O_CKS : O_CVS) + (size_t)(row - MP) * 256;
                    else { const int s = row & 2047; if (s >= 1920) fo = out + (pn == 4 ? O_CKP : O_CVP) + ((size_t)(row >> 11) * 128 + (s - 1920)) * 256; }
                }
                if (rope) {
                    const int pos = row < MP ? (row & 2047) : 2048 + ((row - MP) & 31);
                    const f32x4 ca = *(const f32x4*)(ropc + pos * 32 + d8), cb = *(const f32x4*)(ropc + pos * 32 + d8 + 4);
                    const f32x4 sa = *(const f32x4*)(rops + pos * 32 + d8), sb = *(const f32x4*)(rops + pos * 32 + d8 + 4);
                    const int hb = pn * 256 + wc * 64;
                    const f32x4 x1a = acc[ai][0][m][0], x1b = acc[ai][0][m][1], x2a = acc[ai][1][m][0], x2b = acc[ai][1][m][1];
                    const f32x4 o1a = x1a * ca - x2a * sa, o1b = x1b * cb - x2b * sb, o2a = x2a * ca + x1a * sa, o2b = x2b * cb + x1b * sb;
                    u32x4 p1, p2;
                    p1[0] = cvt_pk_bf16(o1a[0], o1a[1]); p1[1] = cvt_pk_bf16(o1a[2], o1a[3]); p1[2] = cvt_pk_bf16(o1b[0], o1b[1]); p1[3] = cvt_pk_bf16(o1b[2], o1b[3]);
                    p2[0] = cvt_pk_bf16(o2a[0], o2a[1]); p2[1] = cvt_pk_bf16(o2a[2], o2a[3]); p2[2] = cvt_pk_bf16(o2b[0], o2b[1]); p2[3] = cvt_pk_bf16(o2b[2], o2b[3]);
                    *(u32x4*)(ur + hb + d8) = p1; *(u32x4*)(ur + hb + 32 + d8) = p2;
                    if (fo) { float* f1 = fo + (hb - 1024) + d8; *(f32x4*)f1 = o1a; *(f32x4*)(f1 + 4) = o1b; *(f32x4*)(f1 + 32) = o2a; *(f32x4*)(f1 + 36) = o2b; }
                } else {
#pragma unroll
                    for (int bj = 0; bj < 2; ++bj) {
                        const int col = pn * 256 + bj * 128 + wc * 32 + 8 * fq;
                        const f32x4 v0 = acc[ai][bj][m][0], v1 = acc[ai][bj][m][1];
                        u32x4 pk; pk[0] = cvt_pk_bf16(v0[0], v0[1]); pk[1] = cvt_pk_bf16(v0[2], v0[3]); pk[2] = cvt_pk_bf16(v1[0], v1[1]); pk[3] = cvt_pk_bf16(v1[2], v1[3]);
                        *(u32x4*)(ur + col) = pk;
                        if (fo) { *(f32x4*)(fo + (col - 1280)) = v0; *(f32x4*)(fo + (col - 1280) + 4) = v1; }
                    }
                }
            }
    }
};
struct Epi2 {
    static constexpr bool PERM = true, AFTER_DRAIN = false;
    bf16_t* Y; float* ssq;
    __device__ __forceinline__ void operator()(const f32x4 (&acc)[2][2][4][2], const pg8::Unit& u, int wr, int wc, int fr, int fq) const {
#pragma unroll
        for (int ai = 0; ai < 2; ++ai)
#pragma unroll
            for (int m = 0; m < 4; ++m) {
                const int row = u.pm * 256 + ai * 128 + wr * 64 + m * 16 + fr;
                bf16_t* yr = Y + (size_t)row * DM + u.pn * 256 + wc * 32 + 8 * fq;
                float ss = 0.f;
#pragma unroll
                for (int bj = 0; bj < 2; ++bj) {
                    const f32x4 v0 = acc[ai][bj][m][0], v1 = acc[ai][bj][m][1];
                    u32x4 pk; pk[0] = cvt_pk_bf16(v0[0], v0[1]); pk[1] = cvt_pk_bf16(v0[2], v0[3]); pk[2] = cvt_pk_bf16(v1[0], v1[1]); pk[3] = cvt_pk_bf16(v1[2], v1[3]);
                    *(u32x4*)(yr + bj * 128) = pk;
                    ss += v0[0] * v0[0] + v0[1] * v0[1] + v0[2] * v0[2] + v0[3] * v0[3] + v1[0] * v1[0] + v1[1] * v1[1] + v1[2] * v1[2] + v1[3] * v1[3];
                }
                ss += __shfl_xor(ss, 16); ss += __shfl_xor(ss, 32);
                if (fq == 0) ssq[(size_t)row * 16 + u.pn * 4 + wc] = ss;
            }
    }
};

__device__ __forceinline__ void store_bf16x4(bf16_t* dst, f32x4 v) { u32x2 pk; pk[0] = cvt_pk_bf16(v[0], v[1]); pk[1] = cvt_pk_bf16(v[2], v[3]); *(u32x2*)dst = pk; }
__device__ __forceinline__ void store_bf16x8(bf16_t* dst, f32x4 a, f32x4 b) { u32x4 pk; pk[0] = cvt_pk_bf16(a[0], a[1]); pk[1] = cvt_pk_bf16(a[2], a[3]); pk[2] = cvt_pk_bf16(b[0], b[1]); pk[3] = cvt_pk_bf16(b[2], b[3]); *(u32x4*)dst = pk; }
__device__ __forceinline__ f32x4 load_bf16x4(const bf16_t* src) { const u32x2 r = *(const u32x2*)src; f32x4 v; v[0] = bf_lo(r[0]); v[1] = bf_hi(r[0]); v[2] = bf_lo(r[1]); v[3] = bf_hi(r[1]); return v; }
__device__ __forceinline__ const float* xrow(const Params& p, int row) { return row < MP ? p.in[0] + (size_t)row * DM : p.in[1] + (size_t)(row - MP) * DM; }
__device__ __forceinline__ float* yrow(const Params& p, int row) { return p.out + (row < MP ? O_YP + (size_t)row * DM : O_YS + (size_t)(row - MP) * DM); }

template <int NR>
__device__ __forceinline__ void prenorm_rows(const Params& p, int row0, int lane) {
    const float* g = p.in[8];
    bf16_t* xn = (bf16_t*)(p.ws + WS_ACT);
    f32x4 v[NR][4];
#pragma unroll
    for (int r = 0; r < NR; ++r) {
        const float* xr = xrow(p, row0 + r);
#pragma unroll
        for (int i = 0; i < 4; ++i) v[r][i] = *(const f32x4*)(xr + ((i >> 1) * 512 + lane * 8 + (i & 1) * 4));
    }
#pragma unroll
    for (int r = 0; r < NR; ++r) {
        float ss = 0.f;
#pragma unroll
        for (int i = 0; i < 4; ++i) ss += v[r][i][0] * v[r][i][0] + v[r][i][1] * v[r][i][1] + v[r][i][2] * v[r][i][2] + v[r][i][3] * v[r][i][3];
        const float rs = rsqrtf(wave_sum(ss) * (1.0f / 1024.0f) + 1e-6f);
#pragma unroll
        for (int ip = 0; ip < 2; ++ip) { const int c = ip * 512 + lane * 8; const f32x4 g0 = *(const f32x4*)(g + c), g1 = *(const f32x4*)(g + c + 4); store_bf16x8(xn + (size_t)(row0 + r) * DM + c, v[r][2 * ip] * rs * g0, v[r][2 * ip + 1] * rs * g1); }
    }
}

__device__ __forceinline__ void phase_prep(const Params& p, LAS unsigned char* lds) {
    const int tid = opaque_tid(), wid = tid >> 6, lane = tid & 63, bid = opaque_bid(), nb = gridDim.x;
    unsigned char* ws = p.ws;
    if (bid == 0) for (int i = tid; i < 1024 + 4096; i += 512) ((unsigned*)(ws + WS_CTL))[i] = 0u;
    float* ropc = (float*)(ws + WS_ROPC); float* rops = (float*)(ws + WS_ROPS);
    for (int i = bid * 512 + tid; i < 2112 * 32; i += nb * 512) {
        const int pos = i >> 5, d = i & 31;
        const float inv = exp2f(-(float)d * (2.0f / 64.0f) * 13.287712379549449f);
        const float ang = (float)pos * inv;
        const double x = (double)ang, n = rint(x * 0.15915494309189535), r = x - n * 6.283185307179586;
        const float rf = (float)r;
        ropc[i] = __cosf(rf); rops[i] = __sinf(rf);
    }
    LAS float* tl = (LAS float*)lds;
    const int gw = wid * nb + bid, nw = 8 * nb;
    const int nq = (544 - bid + nb - 1) / nb, ng = (MP / 4 - gw + nw - 1) / nw;
    for (int itn = 0; itn < (nq > ng ? nq : ng); ++itn) {
        const int q4 = bid + itn * nb; const bool wq = q4 < 544;
        f32x4 la[4], lb[4];
        if (wq) {
#pragma unroll
            for (int u = 0; u < 4; ++u) {
                const int t = 4 * q4 + u;
                const float* W; int N, tt;
                if (t < 1024) { W = p.in[9]; N = N1; tt = t; }
                else if (t < 1280) { W = p.in[10]; N = DM; tt = t - 1024; }
                else if (t < 1920) { W = p.in[14]; N = N3; tt = t - 1280; }
                else { W = p.in[16]; N = DM; tt = t - 1920; }
                const int n0 = (tt >> 4) * 64, k0 = (tt & 15) * 64;
                const int k = tid >> 3, c = (tid & 7) * 8;
                int scol = n0 + c;
                if (t >= 1280 && t < 1920 && scol < 1280) { const int sl = scol & 255; scol = (scol & ~255) + ((sl >> 5) & 3) * 64 + (sl >> 7) * 32 + (sl & 31); }
                const float* src = W + (size_t)(k0 + k) * N + scol;
                la[u] = *(const f32x4*)src; lb[u] = *(const f32x4*)(src + 4);
            }
        }
        { const int gi = gw + itn * nw; if (gi < MP / 4) prenorm_rows<4>(p, 4 * gi, lane); }
        if (wq) {
#pragma unroll
            for (int u = 0; u < 4; ++u) {
                const int k = tid >> 3, c = (tid & 7) * 8;
#pragma unroll
                for (int j = 0; j < 4; ++j) { tl[u * 4160 + k * 65 + c + j] = la[u][j]; tl[u * 4160 + k * 65 + c + 4 + j] = lb[u][j]; }
            }
            __syncthreads();
#pragma unroll
            for (int u = 0; u < 4; ++u) {
                const int t = 4 * q4 + u;
                bf16_t* WT; int tt; bool perm = false;
                if (t < 1024) { WT = (bf16_t*)(ws + WS_W1T); tt = t; }
                else if (t < 1280) { WT = (bf16_t*)(ws + WS_W2T); tt = t - 1024; }
                else if (t < 1920) { WT = (bf16_t*)(ws + WS_W3T); tt = t - 1280; perm = true; }
                else { WT = (bf16_t*)(ws + WS_W4T); tt = t - 1920; }
                const int n0 = (tt >> 4) * 64, k0 = (tt & 15) * 64;
                const int slot = tid >> 3, kc = (tid & 7) * 8;
                int ncol = slot;
                (void)perm;
                float v[8];
#pragma unroll
                for (int j = 0; j < 8; ++j) v[j] = tl[u * 4160 + (kc + j) * 65 + ncol];
                u32x4 pk; pk[0] = cvt_pk_bf16(v[0], v[1]); pk[1] = cvt_pk_bf16(v[2], v[3]); pk[2] = cvt_pk_bf16(v[4], v[5]); pk[3] = cvt_pk_bf16(v[6], v[7]);
                *(u32x4*)(WT + (size_t)(n0 + slot) * DM + k0 + kc) = pk;
            }
            __syncthreads();
        }
    }
    for (int r = MP + gw; r < MT; r += nw) prenorm_rows<1>(p, r, lane);
}

__device__ __forceinline__ float ssq_total(const float* ssq, int row) {
    const f32x4* sp = (const f32x4*)(ssq + (size_t)row * 16);
    const f32x4 s0 = sp[0], s1 = sp[1], s2 = sp[2], s3 = sp[3];
    return (s0[0] + s0[1] + s0[2] + s0[3]) + (s1[0] + s1[1] + s1[2] + s1[3]) + (s2[0] + s2[1] + s2[2] + s2[3]) + (s3[0] + s3[1] + s3[2] + s3[3]);
}
template <int NR>
__device__ __forceinline__ void mid_rows(const Params& p, int row0, int lane) {
    const bf16_t* y = (const bf16_t*)(p.ws + WS_Y); const float* ssq = (const float*)(p.ws + WS_SSQ); bf16_t* xn = (bf16_t*)(p.ws + WS_ACT);
    const float* gpost = p.in[11]; const float* gpre = p.in[13];
    bf16_t* y1 = (bf16_t*)(p.ws + WS_Y1);
    f32x4 v[NR][4], yv[NR][4]; float st[NR];
#pragma unroll
    for (int r = 0; r < NR; ++r) {
        const float* xr = xrow(p, row0 + r);
        st[r] = ssq_total(ssq, row0 + r);
#pragma unroll
        for (int i = 0; i < 4; ++i) { const int c = ((i >> 1) * 512 + lane * 8 + (i & 1) * 4); v[r][i] = *(const f32x4*)(xr + c); yv[r][i] = load_bf16x4(y + (size_t)(row0 + r) * DM + c); }
    }
    float ss[NR];
#pragma unroll
    for (int r = 0; r < NR; ++r) {
        const float rs = rsqrtf(st[r] * (1.0f / 1024.0f) + 1e-6f);
        ss[r] = 0.f;
#pragma unroll
        for (int i = 0; i < 4; ++i) {
            const int c = ((i >> 1) * 512 + lane * 8 + (i & 1) * 4);
            const f32x4 gp = *(const f32x4*)(gpost + c);
            v[r][i] = v[r][i] + yv[r][i] * rs * gp;
            ss[r] += v[r][i][0] * v[r][i][0] + v[r][i][1] * v[r][i][1] + v[r][i][2] * v[r][i][2] + v[r][i][3] * v[r][i][3];
        }
    }
#pragma unroll
    for (int r = 0; r < NR; ++r) {
#pragma unroll
        for (int ip = 0; ip < 2; ++ip) store_bf16x8(y1 + (size_t)(row0 + r) * DM + ip * 512 + lane * 8, v[r][2 * ip], v[r][2 * ip + 1]);
        const float rs2 = rsqrtf(wave_sum(ss[r]) * (1.0f / 1024.0f) + 1e-6f);
#pragma unroll
        for (int ip = 0; ip < 2; ++ip) { const int c = ip * 512 + lane * 8; const f32x4 g0 = *(const f32x4*)(gpre + c), g1 = *(const f32x4*)(gpre + c + 4); store_bf16x8(xn + (size_t)(row0 + r) * DM + c, v[r][2 * ip] * rs2 * g0, v[r][2 * ip + 1] * rs2 * g1); }
    }
}
__device__ __forceinline__ void phase_mid(const Params& p) {
    const int tid = opaque_tid(), wid = tid >> 6, lane = tid & 63, bid = opaque_bid(), nb = gridDim.x;
    unsigned* cw = (unsigned*)(p.ws + WS_CTL);
    constexpr int NSB = DM / 256;
    if (bid < NSB) {
        block_wait(cw + CW_SAMP(3), NSB);
        for (int r = MP + bid * 8 + wid; r < MT; r += NSB * 8) mid_rows<1>(p, r, lane);
    } else {
        const int w = wid * (nb - NSB) + (bid - NSB), nw = 8 * (nb - NSB);
        const int ngrp = (MP / 4) / nw * nw;
        for (int gi = w; gi < ngrp; gi += nw) mid_rows<4>(p, 4 * gi, lane);
        for (int r = 4 * ngrp + w; r < MP; r += nw) mid_rows<1>(p, r, lane);
    }
}
template <int NR>
__device__ __forceinline__ void fin_rows(const Params& p, int row0, int lane) {
    const bf16_t* y = (const bf16_t*)(p.ws + WS_Y); const float* ssq = (const float*)(p.ws + WS_SSQ);
    const float* gpost = p.in[17];
    const bf16_t* y1 = (const bf16_t*)(p.ws + WS_Y1);
    f32x4 v[NR][4], yv[NR][4]; float st[NR];
#pragma unroll
    for (int r = 0; r < NR; ++r) {
        st[r] = ssq_total(ssq, row0 + r);
#pragma unroll
        for (int i = 0; i < 4; ++i) { const int c = ((i >> 1) * 512 + lane * 8 + (i & 1) * 4); v[r][i] = load_bf16x4(y1 + (size_t)(row0 + r) * DM + c); yv[r][i] = load_bf16x4(y + (size_t)(row0 + r) * DM + c); }
    }
#pragma unroll
    for (int r = 0; r < NR; ++r) {
        const float rs = rsqrtf(st[r] * (1.0f / 1024.0f) + 1e-6f);
        float* o = yrow(p, row0 + r);
#pragma unroll
        for (int i = 0; i < 4; ++i) { const int c = ((i >> 1) * 512 + lane * 8 + (i & 1) * 4); const f32x4 gp = *(const f32x4*)(gpost + c); *(f32x4*)(o + c) = v[r][i] + yv[r][i] * rs * gp; }
    }
}
__device__ __forceinline__ void phase_fin(const Params& p) {
    const int tid = opaque_tid(), wid = tid >> 6, lane = tid & 63, bid = opaque_bid(), nb = gridDim.x;
    unsigned* cw = (unsigned*)(p.ws + WS_CTL);
    constexpr int NSB = DM / 256;
    if (bid < NSB) {
        block_wait(cw + CW_SAMP(7), NSB);
        for (int r = MP + bid * 8 + wid; r < MT; r += NSB * 8) fin_rows<1>(p, r, lane);
    } else {
        const int w = wid * (nb - NSB) + (bid - NSB), nw = 8 * (nb - NSB);
        const int ngrp = (MP / 4) / nw * nw;
        for (int gi = w; gi < ngrp; gi += nw) fin_rows<4>(p, 4 * gi, lane);
        for (int r = 4 * ngrp + w; r < MP; r += nw) fin_rows<1>(p, r, lane);
    }
}

constexpr int KST = 144, VST = 192;
constexpr int L_K = 0, L_V = 4 * 64 * KST, L_BIAS = L_V + 4 * 64 * VST, L_IT = L_BIAS + 1056;

struct AttnItem {
    int kind;
    int t_lo, t_hi;
    int kbase;
    int nkeys;
    int L;
    const float* ck; const float* cv; int cstride;
    const bf16_t* uk; const bf16_t* uv; int ustride;
    const float* bias;
    float* outk; float* outv; int own_lo, own_hi;
    int active; int qpos0; float sink2;
    const bf16_t* q; const bf16_t* g; bf16_t* o;
};

struct TileRegs { u32x4 a, b, c, d; };

template <int KIND, bool PRE = false>
__device__ __forceinline__ void attn_run(const AttnItem& it, LAS unsigned char* lds, int tid, int lane, unsigned* qctr, int& pre) {
    const int l32 = lane & 31, hh = lane >> 5;
    bf16x8 qf[4];
    u32x4 gv[4];
    if (it.active) {
        const bf16_t* qp = it.q + (size_t)l32 * it.ustride + 8 * hh;
        u32x4 raw[4];
#pragma unroll
        for (int kk = 0; kk < 4; ++kk) raw[kk] = *(const u32x4*)(qp + 16 * kk);
        const bf16_t* gp = it.g + (size_t)l32 * it.ustride + 8 * hh;
#pragma unroll
        for (int i = 0; i < 4; ++i) gv[i] = *(const u32x4*)(gp + (i >> 1) * 32 + (i & 1) * 16);
#pragma unroll
        for (int kk = 0; kk < 4; ++kk) {
            u32x4 sc;
#pragma unroll
            for (int j = 0; j < 4; ++j) sc[j] = cvt_pk_bf16(bf_lo(raw[kk][j]) * 0.125f, bf_hi(raw[kk][j]) * 0.125f);
            qf[kk] = __builtin_bit_cast(bf16x8, sc);
        }
    }
    if (KIND == 0) { LAS float* bl = (LAS float*)(lds + L_BIAS); for (int i = tid; i < 257; i += 512) bl[i] = it.bias[i] * LOG2E; }
    const LAS float* biasL = (const LAS float*)(lds + L_BIAS);

    f32x16 o0, o1;
#pragma unroll
    for (int i = 0; i < 16; ++i) { o0[i] = 0.f; o1[i] = 0.f; }
    float mrun = (KIND == 2) ? it.sink2 : -INFINITY;
    float lrun = (KIND == 2 && hh == 0) ? 1.0f : 0.0f;
    float carry = 1.0f;
    bool wdone = false;

    const int lkey = tid >> 3, lc = tid & 7;
    auto issue = [&](int t, TileRegs& R) {
        const int key = 64 * t + lkey;
        const bool f32src = 64 * t < it.L;
        const char* kp; const char* vp;
        if (f32src) { kp = (const char*)(it.ck + (size_t)key * it.cstride + 8 * lc); vp = (const char*)(it.cv + (size_t)key * it.cstride + 8 * lc); }
        else { const int kk = (key < it.nkeys ? key : it.nkeys - 1) - it.L; kp = (const char*)(it.uk + (size_t)kk * it.ustride + 8 * lc); vp = (const char*)(it.uv + (size_t)kk * it.ustride + 8 * lc); }
        R.a = *(const u32x4*)kp; R.b = *(const u32x4*)vp;
        if (f32src) { R.c = *(const u32x4*)(kp + 16); R.d = *(const u32x4*)(vp + 16); }
    };
    auto commit = [&](int t, int buf, const TileRegs& R) {
        u32x4 k16, v16;
        if (64 * t < it.L) {
            const f32x4 ka = __builtin_bit_cast(f32x4, R.a), kb2 = __builtin_bit_cast(f32x4, R.c), va2 = __builtin_bit_cast(f32x4, R.b), vb2 = __builtin_bit_cast(f32x4, R.d);
            k16[0] = cvt_pk_bf16(ka[0], ka[1]); k16[1] = cvt_pk_bf16(ka[2], ka[3]); k16[2] = cvt_pk_bf16(kb2[0], kb2[1]); k16[3] = cvt_pk_bf16(kb2[2], kb2[3]);
            v16[0] = cvt_pk_bf16(va2[0], va2[1]); v16[1] = cvt_pk_bf16(va2[2], va2[3]); v16[2] = cvt_pk_bf16(vb2[0], vb2[1]); v16[3] = cvt_pk_bf16(vb2[2], vb2[3]);
        } else {
            k16 = R.a; v16 = R.b;
            if (t >= it.own_lo && t < it.own_hi) {
                float* ok = it.outk + (size_t)(64 * t + lkey) * 512 + 8 * lc; float* ov = it.outv + (size_t)(64 * t + lkey) * 512 + 8 * lc;
                f32x4 a, b2, c, d2;
                a[0] = bf_lo(k16[0]); a[1] = bf_hi(k16[0]); a[2] = bf_lo(k16[1]); a[3] = bf_hi(k16[1]); b2[0] = bf_lo(k16[2]); b2[1] = bf_hi(k16[2]); b2[2] = bf_lo(k16[3]); b2[3] = bf_hi(k16[3]);
                c[0] = bf_lo(v16[0]); c[1] = bf_hi(v16[0]); c[2] = bf_lo(v16[1]); c[3] = bf_hi(v16[1]); d2[0] = bf_lo(v16[2]); d2[1] = bf_hi(v16[2]); d2[2] = bf_lo(v16[3]); d2[3] = bf_hi(v16[3]);
                *(f32x4*)ok = a; *(f32x4*)(ok + 4) = b2; *(f32x4*)ov = c; *(f32x4*)(ov + 4) = d2;
            }
        }
        *(LAS u32x4*)(lds + L_K + buf * (64 * KST) + lkey * KST + lc * 16) = k16;
        *(LAS u32x4*)(lds + L_V + buf * (64 * VST) + lkey * VST + lc * 16) = v16;
    };
    const unsigned vlane = (unsigned)(size_t)(lds + L_V) + (unsigned)((((lane & 15) >> 2) + 4 * hh) * VST + (16 * ((lane >> 4) & 1) + 4 * (lane & 3)) * 2);

    auto sb_sub = [&](const f32x16& s, int kps, float (&pv)[16]) {
        const bool diag = (kps + 31 >= it.qpos0);
        const int lim = it.qpos0 + l32 - kps - 4 * hh;
        float om[16], sg[16];
#pragma unroll
        for (int i = 0; i < 16; ++i) {
            const float u = fexp2(fminf(s[i] * LOG2E, 80.0f));
            const float r = __builtin_amdgcn_rcpf(1.0f + u);
            om[i] = r; sg[i] = u * r;
        }
        if (diag) {
#pragma unroll
            for (int i = 0; i < 16; ++i) { const bool valid = (8 * (i >> 2) + (i & 3) < lim); om[i] = valid ? om[i] : 1.0f; sg[i] = valid ? sg[i] : 0.0f; }
        }
        float e[16], G[4], Go[4];
#pragma unroll
        for (int g = 0; g < 4; ++g) {
            e[4 * g + 3] = 1.0f; e[4 * g + 2] = om[4 * g + 3]; e[4 * g + 1] = e[4 * g + 2] * om[4 * g + 2]; e[4 * g] = e[4 * g + 1] * om[4 * g + 1];
            G[g] = e[4 * g] * om[4 * g];
        }
#pragma unroll
        for (int g = 0; g < 4; ++g) Go[g] = __shfl_xor(G[g], 32);
        float S[4];
        S[3] = 1.0f; S[2] = G[3] * Go[3]; S[1] = S[2] * (G[2] * Go[2]); S[0] = S[1] * (G[1] * Go[1]);
        const float total = S[0] * (G[0] * Go[0]);
#pragma unroll
        for (int g = 0; g < 4; ++g) {
            const float bl = carry * S[g] * (hh == 0 ? Go[g] : 1.0f);
#pragma unroll
            for (int j = 0; j < 4; ++j) pv[4 * g + j] = sg[4 * g + j] * (bl * e[4 * g + j]);
        }
        carry *= total;
    };
    auto compute = [&](int t, int buf) {
        if (!it.active || wdone) return;
        const int ks0 = 64 * t, kp0 = it.kbase + ks0;
        bool use, v1;
        if (KIND == 1) { use = kp0 < it.qpos0 + 31; v1 = kp0 + 32 < it.qpos0 + 31; }
        else { const int kc = kp0 >> 6, qc = it.qpos0 >> 6; use = (kc <= qc) && (kc >= qc - (KIND == 0 ? 8 : 2)); v1 = ks0 + 32 < it.nkeys; }
        if (!use) return;
        const LAS unsigned char* kb = lds + L_K + buf * (64 * KST) + l32 * KST + 16 * hh;
        bf16x8 kf0[4], kf1[4];
#pragma unroll
        for (int kk = 0; kk < 4; ++kk) { kf0[kk] = *(const LAS bf16x8*)(kb + kk * 32); kf1[kk] = *(const LAS bf16x8*)(kb + 32 * KST + kk * 32); }
        f32x16 s0, s1;
#pragma unroll
        for (int i = 0; i < 16; ++i) { s0[i] = 0.f; s1[i] = 0.f; }
#pragma unroll
        for (int kk = 0; kk < 4; ++kk) {
            s0 = __builtin_amdgcn_mfma_f32_32x32x16_bf16(kf0[kk], qf[kk], s0, 0, 0, 0);
            s1 = __builtin_amdgcn_mfma_f32_32x32x16_bf16(kf1[kk], qf[kk], s1, 0, 0, 0);
        }
        float pa[16], pb[16];
        if (KIND == 1) {
            if (v1) sb_sub(s1, kp0 + 32, pb);
            else {
#pragma unroll
                for (int i = 0; i < 16; ++i) pb[i] = 0.f;
            }
            sb_sub(s0, kp0, pa);
            wdone = __all(carry == 0.0f) != 0;
        } else {
            float sa[16], sb[16];
            if (KIND == 0) {
                if (kp0 + 63 + 128 <= it.qpos0) {
                    const float b256 = biasL[256];
#pragma unroll
                    for (int i = 0; i < 16; ++i) { sa[i] = s0[i] * LOG2E + b256; sb[i] = s1[i] * LOG2E + b256; }
                } else {
                    const int rel0 = it.qpos0 + l32 - kp0 - 4 * hh + 128;
#pragma unroll
                    for (int i = 0; i < 16; ++i) {
                        int r = rel0 - (8 * (i >> 2) + (i & 3));
                        int r1 = r - 32;
                        r = r < 0 ? 0 : (r > 256 ? 256 : r);
                        r1 = r1 < 0 ? 0 : (r1 > 256 ? 256 : r1);
                        sa[i] = s0[i] * LOG2E + biasL[r];
                        sb[i] = s1[i] * LOG2E + biasL[r1];
                    }
                }
            } else {
#pragma unroll
                for (int i = 0; i < 16; ++i) { sa[i] = s0[i] * LOG2E; sb[i] = s1[i] * LOG2E; }
            }
            if (!v1) {
#pragma unroll
                for (int i = 0; i < 16; ++i) sb[i] = -INFINITY;
            }
            float mx = fmaxf(sa[0], sb[0]);
#pragma unroll
            for (int i = 1; i < 16; ++i) mx = fmaxf(mx, fmaxf(sa[i], sb[i]));
            mx = fmaxf(mx, __shfl_xor(mx, 32));
            const float mnew = fmaxf(mrun, mx);
            const float alpha = fexp2(mrun - mnew);
            float rsum = 0.f;
#pragma unroll
            for (int i = 0; i < 16; ++i) { pa[i] = fexp2(sa[i] - mnew); pb[i] = fexp2(sb[i] - mnew); rsum += pa[i] + pb[i]; }
            lrun = lrun * alpha + rsum; mrun = mnew;
            if (!__all(alpha == 1.0f)) {
#pragma unroll
                for (int i = 0; i < 16; ++i) { o0[i] *= alpha; o1[i] *= alpha; }
            }
        }
        {
            const unsigned va = vlane + (unsigned)(buf * 64 * VST);
            u32x2 vf[16];
            asm volatile("ds_read_b64_tr_b16 %0, %16 offset:0\n\tds_read_b64_tr_b16 %1, %16 offset:1536\n\tds_read_b64_tr_b16 %2, %16 offset:64\n\tds_read_b64_tr_b16 %3, %16 offset:1600\n\tds_read_b64_tr_b16 %4, %16 offset:3072\n\tds_read_b64_tr_b16 %5, %16 offset:4608\n\tds_read_b64_tr_b16 %6, %16 offset:3136\n\tds_read_b64_tr_b16 %7, %16 offset:4672\n\tds_read_b64_tr_b16 %8, %16 offset:6144\n\tds_read_b64_tr_b16 %9, %16 offset:7680\n\tds_read_b64_tr_b16 %10, %16 offset:6208\n\tds_read_b64_tr_b16 %11, %16 offset:7744\n\tds_read_b64_tr_b16 %12, %16 offset:9216\n\tds_read_b64_tr_b16 %13, %16 offset:10752\n\tds_read_b64_tr_b16 %14, %16 offset:9280\n\tds_read_b64_tr_b16 %15, %16 offset:10816\n\ts_waitcnt lgkmcnt(0)"
                         : "=&v"(vf[0]), "=&v"(vf[1]), "=&v"(vf[2]), "=&v"(vf[3]), "=&v"(vf[4]), "=&v"(vf[5]), "=&v"(vf[6]), "=&v"(vf[7]), "=&v"(vf[8]), "=&v"(vf[9]), "=&v"(vf[10]), "=&v"(vf[11]), "=&v"(vf[12]), "=&v"(vf[13]), "=&v"(vf[14]), "=&v"(vf[15]) : "v"(va) : "memory");
#pragma unroll
            for (int sub = 0; sub < 2; ++sub) {
                if (sub == 1 && !v1) break;
#pragma unroll
                for (int G2 = 0; G2 < 2; ++G2) {
                    u32x4 pk;
#pragma unroll
                    for (int j = 0; j < 4; ++j) pk[j] = sub == 0 ? cvt_pk_bf16(pa[8 * G2 + 2 * j], pa[8 * G2 + 2 * j + 1]) : cvt_pk_bf16(pb[8 * G2 + 2 * j], pb[8 * G2 + 2 * j + 1]);
                    const bf16x8 pf = __builtin_bit_cast(bf16x8, pk);
                    const int n = 4 * (2 * sub + G2);
                    u32x4 vA, vC; vA[0] = vf[n][0]; vA[1] = vf[n][1]; vA[2] = vf[n + 1][0]; vA[3] = vf[n + 1][1]; vC[0] = vf[n + 2][0]; vC[1] = vf[n + 2][1]; vC[2] = vf[n + 3][0]; vC[3] = vf[n + 3][1];
                    o0 = __builtin_amdgcn_mfma_f32_32x32x16_bf16(__builtin_bit_cast(bf16x8, vA), pf, o0, 0, 0, 0);
                    o1 = __builtin_amdgcn_mfma_f32_32x32x16_bf16(__builtin_bit_cast(bf16x8, vC), pf, o1, 0, 0, 0);
                }
            }
        }
    };
    auto vote = [&]() -> bool {
        if (KIND == 1) return __syncthreads_and((wdone || !it.active) ? 1 : 0) != 0;
        __syncthreads(); return false;
    };

    TileRegs R0, R1;
    int t = it.t_hi - 1, buf = 0;
    bool first = true;
    auto clampt = [&](int tt) { return tt >= it.t_lo ? tt : it.t_lo; };
    if (!PRE) { issue(t, R0); issue(clampt(t - 1), R1); }
    if (PRE) {
        for (int tt = it.t_hi - 1; tt >= it.t_lo; --tt) compute(tt, tt & 3);
    } else
    for (;;) {
        commit(t, 2 * buf, R0);
        commit(clampt(t - 1), 2 * buf + 1, R1);
        if (vote()) break;
        if (first) { first = false; if (tid == 0) pre = (int)atomicAdd(qctr, 1u); }
        issue(clampt(t - 2), R0);
        issue(clampt(t - 3), R1);
        compute(t, 2 * buf);
        if (t - 1 >= it.t_lo) compute(t - 1, 2 * buf + 1);
        buf ^= 1; t -= 2;
        if (t < it.t_lo) break;
    }
    if (it.active) {
        float inv = 1.0f;
        if (KIND != 1) { const float lt = lrun + __shfl_xor(lrun, 32); inv = 1.0f / lt; }
        bf16_t* op = it.o + (size_t)l32 * DM + 8 * hh;
#pragma unroll
        for (int db = 0; db < 2; ++db)
#pragma unroll
            for (int k = 0; k < 2; ++k) {
                float lo[4], hi[4];
#pragma unroll
                for (int j = 0; j < 4; ++j) {
                    const float a = (db == 0 ? o0[8 * k + j] : o1[8 * k + j]) * inv;
                    const float b = (db == 0 ? o0[8 * k + 4 + j] : o1[8 * k + 4 + j]) * inv;
                    const auto sw = __builtin_amdgcn_permlane32_swap(__float_as_uint(a), __float_as_uint(b), false, false);
                    lo[j] = __uint_as_float(sw[0]); hi[j] = __uint_as_float(sw[1]);
                }
                const u32x4 gr = gv[2 * db + k];
                float gq[8];
#pragma unroll
                for (int j = 0; j < 4; ++j) { gq[2 * j] = bf_lo(gr[j]); gq[2 * j + 1] = bf_hi(gr[j]); }
                float r[8];
#pragma unroll
                for (int j = 0; j < 4; ++j) { r[j] = lo[j] * gq[j] / (1.0f + __expf(-gq[j])); r[4 + j] = hi[j] * gq[4 + j] / (1.0f + __expf(-gq[4 + j])); }
                u32x4 pk; pk[0] = cvt_pk_bf16(r[0], r[1]); pk[1] = cvt_pk_bf16(r[2], r[3]); pk[2] = cvt_pk_bf16(r[4], r[5]); pk[3] = cvt_pk_bf16(r[6], r[7]);
                *(u32x4*)(op + db * 32 + 16 * k) = pk;
            }
    }
}

template <int LAYER>
__device__ __forceinline__ void decode_item(const Params& p, int idx, int wid, AttnItem& it) {
    bf16_t* U = (bf16_t*)(p.ws + WS_U); bf16_t* OG = (bf16_t*)(p.ws + WS_ACT);
    it.outk = nullptr; it.outv = nullptr; it.own_lo = 0; it.own_hi = 0;
    it.bias = nullptr; it.ck = nullptr; it.cv = nullptr; it.cstride = 0; it.sink2 = 0.f; it.kbase = 0; it.L = 0;
    if (LAYER == 0) {
        it.ustride = N1;
        if (idx >= 1024 && idx < 1088) {
            const int b = (idx - 1024) >> 3, h = idx & 7;
            it.kind = 1; it.L = 2048; it.nkeys = 2080; it.t_lo = 0; it.t_hi = 33;
            it.ck = p.in[4] + (size_t)b * 2048 * 512 + h * 64; it.cv = p.in[5] + (size_t)b * 2048 * 512 + h * 64; it.cstride = 512;
            const size_t r0 = (size_t)(MP + b * 32) * N1;
            it.uk = U + r0 + 2560 + h * 64; it.uv = U + r0 + 3072 + h * 64;
            it.active = (wid == 0); it.qpos0 = 2048;
            it.q = U + r0 + 2048 + h * 64; it.g = U + r0 + 3584 + h * 64; it.o = OG + (size_t)(MP + b * 32) * DM + 512 + h * 64;
        } else if (idx < 1024) {
            const int j = idx, qb = 7 - (j >> 7), r = j & 127, b = r >> 3, h = r & 7;
            it.kind = 1; it.nkeys = 2048; it.t_lo = 0; it.t_hi = 4 * qb + 4;
            it.own_lo = 4 * qb; it.own_hi = 4 * qb + 4;
            it.outk = p.out + O_BKP + (size_t)(b * 2048) * 512 + h * 64; it.outv = p.out + O_BVP + (size_t)(b * 2048) * 512 + h * 64;
            const size_t r0 = (size_t)(b * 2048) * N1;
            it.uk = U + r0 + 2560 + h * 64; it.uv = U + r0 + 3072 + h * 64;
            it.active = 1; it.qpos0 = qb * 256 + wid * 32;
            const size_t rq = (size_t)(b * 2048 + it.qpos0);
            it.q = U + rq * N1 + 2048 + h * 64; it.g = U + rq * N1 + 3584 + h * 64; it.o = OG + rq * DM + 512 + h * 64;
        } else if (idx >= 1152) {
            const int j = idx - 1152, cq = 7 - (j >> 7), r = j & 127, b = r >> 3, h = r & 7, c0 = 4 * cq;
            it.kind = 0; it.nkeys = 2048; it.t_lo = c0 - 8 < 0 ? 0 : c0 - 8; it.t_hi = c0 + 4;
            if (cq >= 6) {
                it.own_lo = c0; it.own_hi = c0 + 4;
                it.outk = p.out + O_AKP + ((size_t)(b * 512) * 512 + h * 64) - (size_t)1536 * 512; it.outv = p.out + O_AVP + ((size_t)(b * 512) * 512 + h * 64) - (size_t)1536 * 512;
            }
            const size_t r0 = (size_t)(b * 2048) * N1;
            it.uk = U + r0 + 512 + h * 64; it.uv = U + r0 + 1024 + h * 64;
            it.active = 1; it.qpos0 = c0 * 64 + wid * 32;
            const size_t rq = (size_t)(b * 2048 + it.qpos0);
            it.q = U + rq * N1 + h * 64; it.g = U + rq * N1 + 1536 + h * 64; it.o = OG + rq * DM + h * 64;
            it.bias = p.in[12] + h * 257;
        } else {
            const int j = idx - 1088, b = j >> 3, h = j & 7;
            it.kind = 0; it.L = 512; it.nkeys = 544; it.kbase = 1536; it.t_lo = 0; it.t_hi = 9;
            it.ck = p.in[2] + (size_t)b * 512 * 512 + h * 64; it.cv = p.in[3] + (size_t)b * 512 * 512 + h * 64; it.cstride = 512;
            const size_t r0 = (size_t)(MP + b * 32) * N1;
            it.uk = U + r0 + 512 + h * 64; it.uv = U + r0 + 1024 + h * 64;
            it.active = (wid == 0); it.qpos0 = 2048;
            it.q = U + r0 + h * 64; it.g = U + r0 + 1536 + h * 64; it.o = OG + (size_t)(MP + b * 32) * DM + h * 64;
            it.bias = p.in[12] + h * 257;
        }
    } else {
        it.ustride = N3; it.kind = 2;
        if (idx >= 1024 && idx < 1056) {
            const int b = (idx - 1024) >> 2, kvh = idx & 3, hq = kvh * 4 + (wid & 3);
            it.L = 128; it.nkeys = 160; it.kbase = 1920; it.t_lo = 0; it.t_hi = 3;
            it.ck = p.in[6] + (size_t)b * 128 * 256 + kvh * 64; it.cv = p.in[7] + (size_t)b * 128 * 256 + kvh * 64; it.cstride = 256;
            const size_t r0 = (size_t)(MP + b * 32) * N3;
            it.uk = U + r0 + 1024 + kvh * 64; it.uv = U + r0 + 1280 + kvh * 64;
            it.active = (wid < 4); it.qpos0 = 2048; it.sink2 = p.in[15][hq] * LOG2E;
            it.q = U + r0 + hq * 64; it.g = U + r0 + 1536 + hq * 64; it.o = OG + (size_t)(MP + b * 32) * DM + hq * 64;
        } else {
            const int j = idx < 1024 ? idx : idx - 32, c = 31 - (j >> 6), r = j & 63, b = r >> 2, kvh = r & 3, hq = kvh * 4 + (wid >> 1);
            it.nkeys = 2048; it.t_lo = c - 2 < 0 ? 0 : c - 2; it.t_hi = c + 1;
            const size_t r0 = (size_t)(b * 2048) * N3;
            it.uk = U + r0 + 1024 + kvh * 64; it.uv = U + r0 + 1280 + kvh * 64;
            it.active = 1; it.qpos0 = c * 64 + (wid & 1) * 32; it.sink2 = p.in[15][hq] * LOG2E;
            const size_t rq = (size_t)(b * 2048 + it.qpos0);
            it.q = U + rq * N3 + hq * 64; it.g = U + rq * N3 + 1536 + hq * 64; it.o = OG + rq * DM + hq * 64;
        }
    }
}

__device__ __forceinline__ void attn_c_pair(const Params& p, int idx, int wid, LAS unsigned char* lds, int tid, int lane, unsigned* qctr, int& pre) {
    const bf16_t* U = (const bf16_t*)(p.ws + WS_U); bf16_t* OG = (bf16_t*)(p.ws + WS_ACT);
    const int cp = 15 - (idx >> 6), r = idx & 63, b = r >> 2, kvh = r & 3, c0 = 2 * cp;
    const int t_lo = c0 - 2 < 0 ? 0 : c0 - 2, t_hi = c0 + 2;
    const int lkey = tid >> 3, lc = tid & 7;
    u32x4 kr[4], vr[4];
#pragma unroll
    for (int i = 0; i < 4; ++i) {
        const int t = t_lo + i;
        if (t < t_hi) {
            const bf16_t* rp = U + (size_t)(b * 2048 + 64 * t + lkey) * N3 + kvh * 64 + 8 * lc;
            kr[i] = *(const u32x4*)(rp + 1024); vr[i] = *(const u32x4*)(rp + 1280);
        }
    }
    if (tid == 0) pre = (int)atomicAdd(qctr, 1u);
#pragma unroll
    for (int i = 0; i < 4; ++i) {
        const int t = t_lo + i;
        if (t < t_hi) {
            const int sl = t & 3;
            *(LAS u32x4*)(lds + L_K + sl * (64 * KST) + lkey * KST + lc * 16) = kr[i];
            *(LAS u32x4*)(lds + L_V + sl * (64 * VST) + lkey * VST + lc * 16) = vr[i];
        }
    }
    asm volatile("s_waitcnt lgkmcnt(0)" ::: "memory"); __builtin_amdgcn_s_barrier(); asm volatile("" ::: "memory");
    const int hq = kvh * 4 + (wid >> 1);
    const float sink2 = p.in[15][hq] * LOG2E;
#pragma unroll 1
    for (int g = 0; g < 2; ++g) {
        const int c = c0 + g;
        AttnItem it;
        it.kind = 2; it.t_lo = c - 2 < 0 ? 0 : c - 2; it.t_hi = c + 1; it.kbase = 0; it.nkeys = 2048; it.L = 0;
        it.ck = nullptr; it.cv = nullptr; it.cstride = 0; it.uk = nullptr; it.uv = nullptr; it.ustride = N3; it.bias = nullptr;
        it.outk = nullptr; it.outv = nullptr; it.own_lo = 0; it.own_hi = 0;
        it.active = 1; it.qpos0 = c * 64 + (wid & 1) * 32; it.sink2 = sink2;
        const size_t rq = (size_t)(b * 2048 + it.qpos0);
        it.q = U + rq * N3 + hq * 64; it.g = U + rq * N3 + 1536 + hq * 64; it.o = OG + rq * DM + hq * 64;
        int dummy = 0;
        attn_run<2, true>(it, lds, tid, lane, qctr, dummy);
    }
}

template <int LAYER>
__device__ __forceinline__ void phase_attn(const Params& p, LAS unsigned char* lds, int rep) {
    const int tid = opaque_tid(), wid = __builtin_amdgcn_readfirstlane(tid >> 6), lane = tid & 63;
    constexpr int nitems = LAYER == 0 ? 2176 : 1056;
    unsigned* ctr = (unsigned*)(p.ws + WS_CTL) + LAYER * 16 + rep;
    LAS int* itl = (LAS int*)(lds + L_IT);
    if (tid >= 256) __builtin_amdgcn_s_setprio(1);
    __syncthreads();
    if (tid == 0) itl[0] = (int)atomicAdd(ctr, 1u);
    __syncthreads();
    int idx = itl[0], slot = 0;
    bool samp_ok = false;
    while (idx < nitems) {
        int pre = 0;
        if (idx >= 1024 && idx < (LAYER == 0 ? 1152 : 1056) && !samp_ok) { block_wait((unsigned*)(p.ws + WS_CTL) + CW_SAMP(LAYER == 0 ? 1 : 5), LAYER == 0 ? N1 / 256 : N3 / 256); samp_ok = true; }
        if (LAYER == 1 && idx < 1024) attn_c_pair(p, idx, wid, lds, tid, lane, ctr, pre);
        else {
            AttnItem it;
            decode_item<LAYER>(p, idx, wid, it);
            if (LAYER == 0) { if (it.kind == 0) attn_run<0>(it, lds, tid, lane, ctr, pre); else attn_run<1>(it, lds, tid, lane, ctr, pre); }
            else attn_run<2>(it, lds, tid, lane, ctr, pre);
        }
        if (tid == 0) itl[slot ^ 1] = pre;
        asm volatile("s_waitcnt lgkmcnt(0)" ::: "memory"); __builtin_amdgcn_s_barrier(); asm volatile("" ::: "memory");
        slot ^= 1; idx = itl[slot];
    }
    __builtin_amdgcn_s_setprio(0);
}

struct SplitOrder {
    pg8::StaticOrder so; int mode, c, nN;
    __device__ __forceinline__ void init(int N, int G, int c_, int mode_) { so.init(MP, N, G, c_); mode = mode_; c = c_; nN = N / 256; }
    __device__ __forceinline__ bool next(int i, pg8::Unit& u) const {
        if (mode == 0) return so.next(i, u);
        if (i > 0 || c >= nN) return false;
        u.pm = 128; u.pn = c; return true;
    }
    __device__ __forceinline__ void a_ready(const pg8::Unit&) const {}
    __device__ __forceinline__ void done(const pg8::Unit&) const {}
};

#define XB_TMO      128
#define XB_XCNT(j)  (256  + 64 * (j))
#define XB_XSUB(j)  (1280 + 64 * (j))
#define XB_XGEN(j)  (2304 + 64 * (j))
#define XB_TOP      3328
#define XB_TOPGEN   3392
#define XCD_BAR_WORDS 3456
#define XB_SPIN_CAP (1u << 18)

__device__ __forceinline__ unsigned xb_ld(unsigned* p)              { return __hip_atomic_load(p, __ATOMIC_RELAXED, __HIP_MEMORY_SCOPE_AGENT); }
__device__ __forceinline__ unsigned xb_add(unsigned* p, unsigned v) { return __hip_atomic_fetch_add(p, v, __ATOMIC_RELAXED, __HIP_MEMORY_SCOPE_AGENT); }
__device__ __forceinline__ unsigned xb_xcc_id() { return (unsigned)__builtin_amdgcn_s_getreg((3 << 11) | 20) & 0xFu; }
#define XB_SPIN(cond, bar) do { unsigned _sp = 0; while (cond) { __builtin_amdgcn_s_sleep(1); \
    if ((++_sp & 255u) == 0u) { if (xb_ld(&(bar)[XB_TMO])) break; if (_sp > XB_SPIN_CAP) { atomicAdd(&(bar)[XB_TMO], 1u); break; } } } } while (0)

struct XcdBarrier {
    unsigned* bar; unsigned x;
    volatile LAS unsigned* st;
};

__device__ __forceinline__ XcdBarrier xcd_barrier_post(unsigned* bar, volatile LAS unsigned* st) {
    XcdBarrier b; b.bar = bar; b.x = xb_xcc_id(); b.st = st;
    if (threadIdx.x == 0) (void)xb_add(&bar[XB_XCNT(b.x)], 1u);
    return b;
}
__device__ __forceinline__ void xcd_barrier_complete(unsigned* bar, unsigned x, unsigned& nloc, unsigned& nx) {
    const unsigned G = gridDim.x * gridDim.y * gridDim.z;
    unsigned sum, cnt, mine, sp = 0u;
    for (;;) {
        sum = 0u; cnt = 0u; mine = 0u;
#pragma unroll
        for (unsigned j = 0; j < 16; ++j) { const unsigned c = xb_ld(&bar[XB_XCNT(j)]); sum += c; cnt += (c > 0u) ? 1u : 0u; mine = (j == x) ? c : mine; }
        if (sum == G) break;
        __builtin_amdgcn_s_sleep(1);
        if ((++sp & 255u) == 0u) { if (xb_ld(&bar[XB_TMO])) break; if (sp > XB_SPIN_CAP) { atomicAdd(&bar[XB_TMO], 1u); break; } }
    }
    nloc = mine > 0u ? mine : 1u; nx = cnt > 0u ? cnt : 1u;
}

__device__ __forceinline__ void xcd_barrier(const XcdBarrier& b) {
    asm volatile("s_waitcnt vmcnt(0)" ::: "memory");
    __syncthreads();
    if (threadIdx.x == 0) {
        unsigned* bar = b.bar;
        __builtin_amdgcn_s_waitcnt(0);
        unsigned nloc = b.st[0], nx = b.st[1];
        if (nloc == 0u) { xcd_barrier_complete(bar, b.x, nloc, nx); b.st[0] = nloc; b.st[1] = nx; }
        const unsigned old = xb_add(&bar[XB_XSUB(b.x)], 1u);
        const unsigned gen = old / nloc;
        if (old + 1u == (gen + 1u) * nloc) {
            __builtin_amdgcn_fence(__ATOMIC_RELEASE, "agent");
            asm volatile("s_waitcnt vmcnt(0)" ::: "memory");
            const unsigned og = xb_add(&bar[XB_TOP], 1u);
            const unsigned tg = og / nx;
            if (og + 1u == (tg + 1u) * nx) xb_add(&bar[XB_TOPGEN], 1u);
            else XB_SPIN(xb_ld(&bar[XB_TOPGEN]) == tg, bar);
            __builtin_amdgcn_fence(__ATOMIC_ACQUIRE, "agent");
            xb_add(&bar[XB_XGEN(b.x)], 1u);
            asm volatile("s_waitcnt vmcnt(0)" ::: "memory");
        } else {
            XB_SPIN(xb_ld(&bar[XB_XGEN(b.x)]) == gen, bar);
            __builtin_amdgcn_fence(__ATOMIC_ACQUIRE, "agent");
            asm volatile("s_waitcnt vmcnt(0)" ::: "memory");
        }
    }
    __syncthreads();
}

__device__ __forceinline__ void soft_grid_bar(unsigned* word, unsigned nblocks) {
    asm volatile("s_waitcnt vmcnt(0)" ::: "memory");
    __syncthreads();
    if (threadIdx.x == 0) {
        __builtin_amdgcn_fence(__ATOMIC_RELEASE, "agent");
        asm volatile("s_waitcnt vmcnt(0)" ::: "memory");
        __hip_atomic_fetch_add(word, 1u, __ATOMIC_RELAXED, __HIP_MEMORY_SCOPE_AGENT);
        unsigned spins = 0;
        while (__hip_atomic_load(word, __ATOMIC_RELAXED, __HIP_MEMORY_SCOPE_AGENT) < nblocks && ++spins < (1u << 21)) __builtin_amdgcn_s_sleep(1);
        __builtin_amdgcn_fence(__ATOMIC_ACQUIRE, "agent");
        asm volatile("s_waitcnt vmcnt(0)" ::: "memory");
    }
    __syncthreads();
}

__global__ void __launch_bounds__(512, 2) mk_fwd(Params p) {
    extern __shared__ __attribute__((aligned(16))) unsigned char shm[];
    LAS unsigned char* lds = (LAS unsigned char*)shm;
    cg::grid_group grid = cg::this_grid();
#ifndef REPM
#define REPM 0
#endif
    unsigned* cw = (unsigned*)(p.ws + WS_CTL);
    volatile LAS unsigned* xst = (volatile LAS unsigned*)(lds + 131072);
    if (threadIdx.x == 0) { xst[0] = 0u; xst[1] = 0u; }
    __syncthreads();
    XcdBarrier xb; xb.bar = (unsigned*)(p.ws + WS_XB); xb.x = 0; xb.st = xst;
    for (int ph = p.ph_lo; ph < p.ph_hi; ++ph) {
        if (ph == 1) { grid.sync(); xb = xcd_barrier_post((unsigned*)(p.ws + WS_XB), xst); }
        else if (ph == 3 || ph == 5 || ph == 7) xcd_barrier(xb);
        if (ph == 0) phase_prep(p, lds);
        else if (ph == 1) {
            for (int part = 0; part < 2; ++part) {
                const int bid = opaque_bid();
                if (part == 1) { xcd_barrier(xb); if (bid >= N1 / 256) break; }
                pg8::Gemm g; g.A = (const bf16_t*)(p.ws + WS_ACT); g.Bt = (const bf16_t*)(p.ws + WS_W1T); g.M = MT; g.N = N1; g.K = DM;
                SplitOrder S; S.init(N1, (int)gridDim.x, bid, part);
                Epi1 E; E.U = (bf16_t*)(p.ws + WS_U); E.out = p.out;
                pg8::gemm_phase<Epi1, SplitOrder>(lds, g, S, E);
                if (part == 1) block_signal(cw + CW_SAMP(ph));
            }
        } else if (ph == 2) phase_attn<0>(p, lds, 0);
        else if (ph == 3 || ph == 7) {
            for (int part = 0; part < 2; ++part) {
                const int bid = opaque_bid();
                if (part == 1) { xcd_barrier(xb); if (bid >= DM / 256) break; }
                pg8::Gemm g; g.A = (const bf16_t*)(p.ws + WS_ACT); g.Bt = (const bf16_t*)(p.ws + (ph == 3 ? WS_W2T : WS_W4T)); g.M = MT; g.N = DM; g.K = DM;
                SplitOrder S; S.init(DM, (int)gridDim.x, bid, part);
                Epi2 E; E.Y = (bf16_t*)(p.ws + WS_Y); E.ssq = (float*)(p.ws + WS_SSQ);
                pg8::gemm_phase<Epi2, SplitOrder>(lds, g, S, E);
                if (part == 1) block_signal(cw + CW_SAMP(ph));
            }
        } else if (ph == 4) phase_mid(p);
        else if (ph == 5) {
            for (int part = 0; part < 2; ++part) {
                const int bid = opaque_bid();
                if (part == 1) { xcd_barrier(xb); if (bid >= N3 / 256) break; }
                pg8::Gemm g; g.A = (const bf16_t*)(p.ws + WS_ACT); g.Bt = (const bf16_t*)(p.ws + WS_W3T); g.M = MT; g.N = N3; g.K = DM;
                SplitOrder S; S.init(N3, (int)gridDim.x, bid, part);
                Epi3 E; E.U = (bf16_t*)(p.ws + WS_U); E.out = p.out; E.ropc = (const float*)(p.ws + WS_ROPC); E.rops = (const float*)(p.ws + WS_ROPS);
                pg8::gemm_phase<Epi3, SplitOrder>(lds, g, S, E);
                if (part == 1) block_signal(cw + CW_SAMP(ph));
            }
        } else if (ph == 6) phase_attn<1>(p, lds, 0);
        else phase_fin(p);
    }
}

constexpr int LDS_BYTES = 131072 + 16;
constexpr int N_PHASES = 9;
#ifndef MK_LAUNCHES
#define MK_LAUNCHES 1
#endif

extern "C" void kernel_launch(void* const* d_in, const int* in_sizes, int n_in, void* d_out, int out_size, void* d_ws, size_t ws_size, hipStream_t stream) {
    static int grid = 0;
    if (grid == 0) {
        if (n_in != 18 || (size_t)out_size != O_END || ws_size < WS_END) { fprintf(stderr, "kernel_launch: unexpected shapes (n_in %d out %d ws %zu)\n", n_in, out_size, ws_size); grid = -1; return; }
        int dev = 0, cus = 0, per_cu = 0;
        hipGetDevice(&dev);
        hipDeviceGetAttribute(&cus, hipDeviceAttributeMultiprocessorCount, dev);
        hipFuncSetAttribute((const void*)mk_fwd, hipFuncAttributeMaxDynamicSharedMemorySize, LDS_BYTES);
        hipOccupancyMaxActiveBlocksPerMultiprocessor(&per_cu, (const void*)mk_fwd, 512, LDS_BYTES);
        if (per_cu < 1) { fprintf(stderr, "kernel_launch: occupancy query says %d blocks per CU\n", per_cu); per_cu = 1; }
        grid = cus * per_cu;
        fprintf(stderr, "kernel_launch: grid %d (%d CUs x %d)\n", grid, cus, per_cu);
    }
    if (grid < 0) return;
    Params p{};
    for (int i = 0; i < 18; ++i) p.in[i] = (const float*)d_in[i];
    p.out = (float*)d_out; p.ws = (unsigned char*)d_ws;
#if MK_LAUNCHES == 1
    p.ph_lo = 0; p.ph_hi = N_PHASES;
    void* args[] = {&p};
    hipError_t e = hipLaunchCooperativeKernel((const void*)mk_fwd, dim3(grid), dim3(512), args, LDS_BYTES, stream);
    if (e != hipSuccess) fprintf(stderr, "cooperative launch failed: %s (grid %d)\n", hipGetErrorString(e), grid);
#else
    for (int ph = 0; ph < N_PHASES; ++ph) {
        p.ph_lo = ph; p.ph_hi = ph + 1;
        hipLaunchKernelGGL(mk_fwd, dim3(grid), dim3(512), LDS_BYTES, stream, p);
    }
#endif
}
```
